# Optimizing an MI355X kernel written in HIP

```python
import math
import jax, jax.numpy as jnp
from jax import lax
import numpy as np

D_MODEL = 1024
BATCH = 16
SEQ = 2048
DEPTH = 1
DEC_BATCH = 32
DEC_SEQ = 64
PAST_LEN = 2048

CHUNK = 64
N_HEADS = 8
HEAD_DIM = D_MODEL // N_HEADS
DK = HEAD_DIM // 2
SCALE = DK ** -0.5
N_BUCKETS = 32
MAX_DIST = 128
Q_BLOCK = 128
GM_CHUNK = 128
GM_GROUPS = 8
GM_WIDTH = D_MODEL
GM_GROUP_DIM = GM_WIDTH // GM_GROUPS
D_FF = ((8 * D_MODEL // 3 + 255) // 256) * 256
Q_W = N_HEADS * 2 * DK
K_W = N_HEADS * 2 * DK
V_W = N_HEADS * HEAD_DIM
IN_SIZES = [Q_W, K_W, V_W, GM_WIDTH, GM_WIDTH, D_MODEL, D_MODEL]
IN_W = sum(IN_SIZES)
SPLITS = [int(s) for s in np.cumsum(IN_SIZES)[:-1]]
EPS = 1e-6
NEG = -1e30

kernel_name = "hybrid_diffattn_gmlp_stream_step"


def rms_norm(x, g):
    xf = x.astype(jnp.float32)
    y = xf * lax.rsqrt(jnp.mean(xf * xf, axis=-1, keepdims=True) + EPS)
    return (y * g.astype(jnp.float32)).astype(x.dtype)


def rel_bucket(rel):
    half = N_BUCKETS // 2
    max_exact = half // 2
    ret = jnp.where(rel > 0, half, 0)
    n = jnp.abs(rel)
    nf = jnp.maximum(n, 1).astype(jnp.float32)
    large = max_exact + (jnp.log(nf / max_exact) / math.log(MAX_DIST / max_exact)
                         * (half - max_exact)).astype(jnp.int32)
    large = jnp.minimum(large, half - 1)
    return ret + jnp.where(n < max_exact, n, large)


def rel_bias(table, q_pos, k_pos):
    bucket = rel_bucket(k_pos[None, :] - q_pos[:, None])
    return jnp.moveaxis(table[bucket].astype(jnp.float32), -1, 0)


def project_inputs(x, norm1_g, w_in, q_norm_g, k_norm_g, gm_norm_g):
    B, T, _ = x.shape
    h = rms_norm(x, norm1_g)
    q, k, v, gu, gv, ga, gg = jnp.split(h @ w_in, SPLITS, axis=-1)
    q = rms_norm(q.reshape(B, T, N_HEADS, 2, DK), q_norm_g)
    k = rms_norm(k.reshape(B, T, N_HEADS, 2, DK), k_norm_g)
    v = v.reshape(B, T, N_HEADS, HEAD_DIM)
    gu = jax.nn.gelu(gu)
    gv = rms_norm(jax.nn.gelu(gv), gm_norm_g)
    return q, k, v, gu, gv, ga, gg


def diff_lambda(lq1, lk1, lq2, lk2, lam_init):
    f = lambda a, b: jnp.exp(jnp.sum(a.astype(jnp.float32) * b.astype(jnp.float32)))
    return f(lq1, lk1) - f(lq2, lk2) + lam_init


def diff_attend(q, k, v, q_pos, k_pos, rel_table, lam, subln_g, lam_init):
    B, Tq = q.shape[:2]
    mask = (k_pos[None, :] // CHUNK) <= (q_pos[:, None] // CHUNK)
    bias = rel_bias(rel_table, q_pos, k_pos)
    s = jnp.einsum('bqhmd,bkhmd->bhmqk', q, k).astype(jnp.float32) * SCALE + bias[None, :, None]
    p = jax.nn.softmax(jnp.where(mask, s, NEG), axis=-1)
    a = p[:, :, 0] - lam * p[:, :, 1]
    o = jnp.einsum('bhqk,bkhd->bqhd', a.astype(v.dtype), v)
    o = rms_norm(o, subln_g) * (1.0 - lam_init)
    return o.reshape(B, Tq, N_HEADS * HEAD_DIM)


def prompt_attention(q, k, v, rel_table, lam, subln_g, lam_init):
    B, S = q.shape[:2]
    nb = S // Q_BLOCK
    qb = q.reshape(B, nb, Q_BLOCK, N_HEADS, 2, DK).swapaxes(0, 1)
    k_pos = jnp.arange(S)

    def one(args):
        q_blk, i = args
        q_pos = i * Q_BLOCK + jnp.arange(Q_BLOCK)
        return diff_attend(q_blk, k, v, q_pos, k_pos, rel_table, lam, subln_g, lam_init)

    o = lax.map(one, (qb, jnp.arange(nb)))
    return o.swapaxes(0, 1).reshape(B, S, V_W)


def gmlp_prompt(gu, gv, w_s, b):
    B, S, _ = gv.shape
    nc = S // GM_CHUNK
    vv = gv.reshape(B, nc, GM_CHUNK, GM_GROUPS, GM_GROUP_DIM)
    wm = (w_s * jnp.tril(jnp.ones((GM_CHUNK, GM_CHUNK), w_s.dtype))).astype(vv.dtype)
    z = jnp.einsum('gts,bnsgc->bntgc', wm, vv) + b.T[None, None, :, :, None].astype(vv.dtype)
    return gu * z.reshape(B, S, GM_WIDTH)


def gmlp_sample(gu, gv, w_s, b):
    B, T, _ = gv.shape
    wm = (w_s * jnp.tril(jnp.ones((GM_CHUNK, GM_CHUNK), w_s.dtype)))[:, :T, :T].astype(gv.dtype)
    z = jnp.einsum('gts,bsgc->btgc', wm, gv.reshape(B, T, GM_GROUPS, GM_GROUP_DIM))
    z = z + b[:, :T].T[None, :, :, None].astype(gv.dtype)
    return gu * z.reshape(B, T, GM_WIDTH)


def merge(attn, gm, ga, gg, w_ab, w_gb, w_out):
    y = jax.nn.sigmoid(ga) * (attn @ w_ab) + jax.nn.sigmoid(gg) * (gm @ w_gb)
    return y @ w_out


def swiglu_ffn(x, norm2_g, w_ffn_in, w_ffn_out):
    g, u = jnp.split(rms_norm(x, norm2_g) @ w_ffn_in, 2, axis=-1)
    return (jax.nn.silu(g) * u) @ w_ffn_out


def setup_inputs(seed: int = 0) -> dict:
    key = jax.random.key(seed)
    ks = jax.random.split(key, 24)
    nrm = lambda k, shape, s: jax.random.normal(k, shape, jnp.float32) * s
    gain = lambda k, shape: 1.0 + 0.02 * jax.random.normal(k, shape, jnp.float32)
    return {
        "x_prompt": nrm(ks[0], (BATCH, SEQ, D_MODEL), 1.0),
        "x_sample": nrm(ks[1], (DEC_BATCH, DEC_SEQ, D_MODEL), 1.0),
        "cache_k": nrm(ks[2], (DEPTH, DEC_BATCH, PAST_LEN, N_HEADS, 2, DK), 1.0),
        "cache_v": nrm(ks[3], (DEPTH, DEC_BATCH, PAST_LEN, N_HEADS, HEAD_DIM), 1.0),
        "rel_table": nrm(ks[4], (N_BUCKETS, N_HEADS), 0.5),
        "norm1_g": gain(ks[5], (DEPTH, D_MODEL)),
        "w_in": nrm(ks[6], (DEPTH, D_MODEL, IN_W), D_MODEL ** -0.5),
        "q_norm_g": gain(ks[7], (DEPTH, DK)),
        "k_norm_g": gain(ks[8], (DEPTH, DK)),
        "lambda_q1": nrm(ks[9], (DEPTH, DK), 0.1),
        "lambda_k1": nrm(ks[10], (DEPTH, DK), 0.1),
        "lambda_q2": nrm(ks[11], (DEPTH, DK), 0.1),
        "lambda_k2": nrm(ks[12], (DEPTH, DK), 0.1),
        "subln_g": gain(ks[13], (DEPTH, HEAD_DIM)),
        "gm_norm_g": gain(ks[14], (DEPTH, GM_WIDTH)),
        "gm_w_s": nrm(ks[15], (DEPTH, GM_GROUPS, GM_CHUNK, GM_CHUNK), GM_CHUNK ** -0.5),
        "gm_b": gain(ks[16], (DEPTH, GM_GROUPS, GM_CHUNK)),
        "w_attn_branch": nrm(ks[17], (DEPTH, V_W, D_MODEL), V_W ** -0.5),
        "w_gmlp_branch": nrm(ks[18], (DEPTH, GM_WIDTH, D_MODEL), GM_WIDTH ** -0.5),
        "w_out": nrm(ks[19], (DEPTH, D_MODEL, D_MODEL), D_MODEL ** -0.5),
        "norm2_g": gain(ks[20], (DEPTH, D_MODEL)),
        "w_ffn_in": nrm(ks[21], (DEPTH, D_MODEL, 2 * D_FF), D_MODEL ** -0.5),
        "w_ffn_out": nrm(ks[22], (DEPTH, D_FF, D_MODEL), D_FF ** -0.5),
    }


def reference(x_prompt, x_sample, cache_k, cache_v, rel_table, norm1_g, w_in, q_norm_g,
              k_norm_g, lambda_q1, lambda_k1, lambda_q2, lambda_k2, subln_g, gm_norm_g,
              gm_w_s, gm_b, w_attn_branch, w_gmlp_branch, w_out, norm2_g, w_ffn_in,
              w_ffn_out):
    xp, xs = x_prompt, x_sample
    past = cache_k.shape[2]
    T = xs.shape[1]
    kp_l, vp_l, ks_l, vs_l, gms_l = [], [], [], [], []
    for l in range(DEPTH):
        lam_init = 0.8 - 0.6 * math.exp(-0.3 * l)
        lam = diff_lambda(lambda_q1[l], lambda_k1[l], lambda_q2[l], lambda_k2[l], lam_init)

        q, k, v, gu, gv, ga, gg = project_inputs(xp, norm1_g[l], w_in[l], q_norm_g[l],
                                                 k_norm_g[l], gm_norm_g[l])
        att = prompt_attention(q, k, v, rel_table, lam, subln_g[l], lam_init)
        gm = gmlp_prompt(gu, gv, gm_w_s[l], gm_b[l])
        xp = xp + merge(att, gm, ga, gg, w_attn_branch[l], w_gmlp_branch[l], w_out[l])
        xp = xp + swiglu_ffn(xp, norm2_g[l], w_ffn_in[l], w_ffn_out[l])
        kp_l.append(k)
        vp_l.append(v)

        q, k, v, gu, gv, ga, gg = project_inputs(xs, norm1_g[l], w_in[l], q_norm_g[l],
                                                 k_norm_g[l], gm_norm_g[l])
        k_all = jnp.concatenate([cache_k[l].astype(k.dtype), k], axis=1)
        v_all = jnp.concatenate([cache_v[l].astype(v.dtype), v], axis=1)
        q_pos = past + jnp.arange(T)
        k_pos = jnp.arange(past + T)
        att = diff_attend(q, k_all, v_all, q_pos, k_pos, rel_table, lam, subln_g[l], lam_init)
        gm = gmlp_sample(gu, gv, gm_w_s[l], gm_b[l])
        xs = xs + merge(att, gm, ga, gg, w_attn_branch[l], w_gmlp_branch[l], w_out[l])
        xs = xs + swiglu_ffn(xs, norm2_g[l], w_ffn_in[l], w_ffn_out[l])
        ks_l.append(k)
        vs_l.append(v)
        gms_l.append(gv)

    new_k_prompt = jnp.stack(kp_l)
    new_v_prompt = jnp.stack(vp_l)
    new_k_sample = jnp.stack(ks_l)
    new_v_sample = jnp.stack(vs_l)
    new_gm_v_sample = jnp.stack(gms_l)
    return (xp, xs, new_k_prompt, new_v_prompt, new_k_sample, new_v_sample, new_gm_v_sample)
```

```cpp
#include <hip/hip_runtime.h>
#include <hip/hip_cooperative_groups.h>
#include <cstdio>
#include <cstdint>
#include <type_traits>
namespace cg = cooperative_groups;
__device__ __forceinline__ int my_lane() { int l; asm volatile("v_mbcnt_lo_u32_b32 %0, -1, 0\n\tv_mbcnt_hi_u32_b32 %0, -1, %0" : "=v"(l)); return l; }
namespace pg8 {
#define PG8_LAS __attribute__((address_space(3)))
typedef unsigned short bf16_t;
typedef short bf16x8 __attribute__((ext_vector_type(8)));
typedef float f32x4 __attribute__((ext_vector_type(4)));
typedef float f32x2 __attribute__((ext_vector_type(2)));
typedef unsigned u32x4 __attribute__((ext_vector_type(4)));
typedef unsigned u32x2 __attribute__((ext_vector_type(2)));
constexpr int BM = 256, BK = 64, HALF = 128, HTB = HALF * BK * 2  , STAGE_BYTES = 8 * HTB, NXCD = 8, WGM = 8;

__host__ __device__ __forceinline__ int lds_byte(int r, int c) { const int st = (r >> 4) * 2 + (c >> 5), rr = r & 15, cc = c & 31, ob = rr * 64 + cc * 2; return st * 1024 + (ob ^ (((ob >> 9) & 1) << 5)); }
__host__ __device__ __forceinline__ void stage_rc(int b, int& R, int& C) { const int st = b / 1024, sb = b % 1024, swz = sb ^ (((sb >> 9) & 1) << 5); R = (st >> 1) * 16 + swz / 64; C = (st & 1) * 32 + (swz % 64) / 2; }
__host__ __device__ __forceinline__ int perm32(int rho) { const int n = rho >> 4, i = rho & 15; return 8 * (i >> 2) + 4 * n + (i & 3); }

struct Unit { int pm, pn; };
struct Gemm { const bf16_t* A; const bf16_t* Bt; int M, N, K; };

struct StaticOrder {
    int nM, nN, nwg, G, c;
    __host__ __device__ void init(int M, int N, int G_, int c_) { nM = M / BM; nN = N / BM; nwg = nM * nN; G = G_; c = c_; }
    __host__ __device__ bool next(int i, Unit& u) const {
        const long L = (long)i * G + c; if (L >= nwg) return false;
        int wgid = (int)L; { const int q = nwg / NXCD, r = nwg % NXCD, xcd = wgid % NXCD, off = wgid / NXCD; wgid = (xcd < r ? xcd * (q + 1) : r * (q + 1) + (xcd - r) * q) + off; }
        const int nig = WGM * nN, gid = wgid / nig, fm = gid * WGM, gsz = (nM - fm) < WGM ? (nM - fm) : WGM;
        u.pm = fm + ((wgid % nig) % gsz); u.pn = (wgid % nig) / gsz; return true;
    }
    __device__ __forceinline__ void a_ready(const Unit&) const {}
    __device__ __forceinline__ void done(const Unit&) const {}
};

__device__ __forceinline__ unsigned cvt_pk_bf16(float lo, float hi) { unsigned r; asm volatile("v_cvt_pk_bf16_f32 %0, %1, %2" : "=v"(r) : "v"(lo), "v"(hi)); return r; }
__device__ __forceinline__ float bf_lo(unsigned w) { return __uint_as_float(w << 16); }
__device__ __forceinline__ float bf_hi(unsigned w) { return __uint_as_float(w & 0xffff0000u); }

template <class Epi, class Sched, bool ALIGN_EPI = false, bool SP2 = false>
__device__ __forceinline__ void gemm_phase(PG8_LAS unsigned char* lds, const Gemm g, const Sched& S, const Epi& E, const int wid) {
    const int lane = my_lane(), tid = wid * 64 + lane, wr = wid >> 2, wc = wid & 3, fr = lane & 15, fq = lane >> 4;
    const int K = g.K, nt = K / BK;
    unsigned voffA[2], voffB[2];
#pragma unroll
    for (int i = 0; i < 2; ++i) { int R, C; stage_rc(tid * 16 + i * 8192, R, C); const int Rb = Epi::PERM ? ((R & ~31) + perm32(R & 31)) : R;
        voffA[i] = (unsigned)(R * K + C) * 2u; voffB[i] = (unsigned)(Rb * K + C) * 2u; }
    const size_t kstep = (size_t)(BK * 2);
    const size_t hstep = (size_t)HALF * K * 2;
    const size_t tstep = 2 * hstep;
    const unsigned ldsw = (unsigned)wid * 1024u;
    const int aoff = lds_byte(wr * 64 + fr, fq * 8), boff = lds_byte(wc * 32 + fr, fq * 8);
#define PG8_SA(b, h) (((b) * 2 + (h)) * HTB)
#define PG8_SB(b, h) ((4 + (b) * 2 + (h)) * HTB)
#define PG8_STAGE(bufoff, gbase, voff) do { _Pragma("unroll") for (int _i = 0; _i < 2; ++_i) \
        __builtin_amdgcn_global_load_lds((const unsigned*)((const char*)(gbase) + (voff)[_i]), (PG8_LAS unsigned*)(lds + (bufoff) + ldsw + _i * 8192), 16, 0, 0); } while (0)
#define PG8_LDA(dst, b, h) do { _Pragma("unroll") for (int m = 0; m < 4; ++m) _Pragma("unroll") for (int k = 0; k < 2; ++k) dst[m][k] = *(const PG8_LAS bf16x8*)(lds + PG8_SA(b, h) + aoff + m * 2048 + k * 1024); } while (0)
#define PG8_LDB(dst, b, h) do { _Pragma("unroll") for (int n = 0; n < 2; ++n) _Pragma("unroll") for (int k = 0; k < 2; ++k) dst[n][k] = *(const PG8_LAS bf16x8*)(lds + PG8_SB(b, h) + boff + n * 2048 + k * 1024); } while (0)
#define PG8_MMA(ai, bj, At, Bt) do { __builtin_amdgcn_s_setprio(1); _Pragma("unroll") for (int m = 0; m < 4; ++m) _Pragma("unroll") for (int n = 0; n < 2; ++n) _Pragma("unroll") for (int k = 0; k < 2; ++k) \
        acc[ai][bj][m][n] = __builtin_amdgcn_mfma_f32_16x16x32_bf16(Bt[n][k], At[m][k], acc[ai][bj][m][n], 0, 0, 0); __builtin_amdgcn_s_setprio(0); } while (0)
#define PG8_WAIT_V(n) asm volatile("s_waitcnt vmcnt(" #n ")" ::: "memory")
#define PG8_WAIT_L(n) asm volatile("s_waitcnt lgkmcnt(" #n ")" ::: "memory")
#define PG8_BAR __builtin_amdgcn_s_barrier()
#define PG8_SCHED __builtin_amdgcn_sched_barrier(0)
    Unit cur, nxt; int ui = 0;
    if (!S.next(0, cur)) return;
    f32x4 acc[2][2][4][2];
#pragma unroll
    for (int a = 0; a < 2; ++a)
#pragma unroll
        for (int b = 0; b < 2; ++b)
#pragma unroll
            for (int m = 0; m < 4; ++m)
#pragma unroll
                for (int n = 0; n < 2; ++n) acc[a][b][m][n] = (f32x4){0.f, 0.f, 0.f, 0.f};
    bf16x8 At[4][2], B0[2][2], B1[2][2];
    const char* cA = (const char*)g.A + (size_t)cur.pm * tstep; const char* cB = (const char*)g.Bt + (size_t)cur.pn * tstep;
    S.a_ready(cur);
    if constexpr (SP2) {
        PG8_STAGE(PG8_SB(0, 0), cB, voffB); PG8_STAGE(PG8_SB(0, 1), cB + hstep, voffB); PG8_STAGE(PG8_SA(0, 0), cA, voffA); PG8_STAGE(PG8_SA(0, 1), cA + hstep, voffA);
        if (wr == 1) PG8_BAR;
        PG8_WAIT_V(2); PG8_BAR;
        PG8_STAGE(PG8_SB(1, 0), cB + kstep, voffB); PG8_STAGE(PG8_SA(1, 0), cA + kstep, voffA); PG8_STAGE(PG8_SB(1, 1), cB + hstep + kstep, voffB);
        PG8_WAIT_V(6); PG8_BAR;
    } else {
        PG8_STAGE(PG8_SB(0, 0), cB, voffB); PG8_STAGE(PG8_SA(0, 0), cA, voffA); PG8_STAGE(PG8_SB(0, 1), cB + hstep, voffB); PG8_STAGE(PG8_SA(0, 1), cA + hstep, voffA);
        if (wr == 1) PG8_BAR;
        PG8_WAIT_V(4); PG8_BAR;
        PG8_STAGE(PG8_SB(1, 0), cB + kstep, voffB); PG8_STAGE(PG8_SA(1, 0), cA + kstep, voffA); PG8_STAGE(PG8_SB(1, 1), cB + hstep + kstep, voffB);
        PG8_WAIT_V(6); PG8_BAR;
    }
    for (;;) {
        const bool has_next = S.next(ui + 1, nxt);
        const char* nA = has_next ? (const char*)g.A + (size_t)nxt.pm * tstep : cA; const char* nB = has_next ? (const char*)g.Bt + (size_t)nxt.pn * tstep : cB;
        for (int t = 0; t < nt; t += 2) {
            const bool last = (t == nt - 2);
            const char* a1 = cA + (size_t)(t + 1) * kstep;
            const char* a2 = last ? nA : cA + (size_t)(t + 2) * kstep; const char* b2 = last ? nB : cB + (size_t)(t + 2) * kstep;
            const char* a3 = a2 + kstep; const char* b3 = b2 + kstep;
            if (last && has_next) S.a_ready(nxt);
            if constexpr (Epi::HAS_MID) { if (t == (nt >> 1)) E.mid(acc, cur, wr, wc, fr, fq); }
            if constexpr (SP2) {
            PG8_LDB(B0, 0, 0); PG8_LDB(B1, 0, 1); PG8_SCHED; PG8_LDA(At, 0, 0); PG8_STAGE(PG8_SA(1, 1), a1 + hstep, voffA);
            PG8_WAIT_V(8); PG8_WAIT_L(0); PG8_BAR; PG8_MMA(0, 0, At, B0); PG8_MMA(0, 1, At, B1); PG8_BAR; PG8_SCHED;
            PG8_LDA(At, 0, 1); PG8_STAGE(PG8_SB(0, 0), b2, voffB); PG8_STAGE(PG8_SB(0, 1), b2 + hstep, voffB); PG8_STAGE(PG8_SA(0, 0), a2, voffA);
            PG8_WAIT_V(8); PG8_WAIT_L(0); PG8_BAR; PG8_MMA(1, 0, At, B0); PG8_MMA(1, 1, At, B1); PG8_BAR; PG8_SCHED;
            PG8_LDB(B0, 1, 0); PG8_LDB(B1, 1, 1); PG8_SCHED; PG8_LDA(At, 1, 0); PG8_STAGE(PG8_SA(0, 1), a2 + hstep, voffA);
            PG8_WAIT_V(8); PG8_WAIT_L(0); PG8_BAR; PG8_MMA(0, 0, At, B0); PG8_MMA(0, 1, At, B1); PG8_BAR; PG8_SCHED;
            PG8_LDA(At, 1, 1); PG8_STAGE(PG8_SB(1, 0), b3, voffB); PG8_STAGE(PG8_SB(1, 1), b3 + hstep, voffB); PG8_STAGE(PG8_SA(1, 0), a3, voffA);
            PG8_WAIT_V(8); PG8_WAIT_L(0); PG8_BAR; PG8_MMA(1, 0, At, B0); PG8_MMA(1, 1, At, B1); PG8_BAR; PG8_SCHED;
            } else {
            PG8_LDB(B0, 0, 0); PG8_SCHED; PG8_LDA(At, 0, 0); PG8_STAGE(PG8_SA(1, 1), a1 + hstep, voffA);
            PG8_WAIT_L(8); PG8_BAR; PG8_WAIT_L(0); PG8_MMA(0, 0, At, B0); PG8_BAR; PG8_SCHED;
            PG8_LDB(B1, 0, 1); PG8_STAGE(PG8_SB(0, 0), b2, voffB);
            PG8_BAR; PG8_WAIT_L(0); PG8_MMA(0, 1, At, B1); PG8_BAR;
            PG8_LDA(At, 0, 1); PG8_STAGE(PG8_SA(0, 0), a2, voffA);
            PG8_BAR; PG8_WAIT_L(0); PG8_MMA(1, 0, At, B0); PG8_BAR; PG8_SCHED;
            PG8_STAGE(PG8_SB(0, 1), b2 + hstep, voffB);
            PG8_WAIT_V(6); PG8_BAR; PG8_MMA(1, 1, At, B1); PG8_BAR;
            PG8_LDB(B0, 1, 0); PG8_SCHED; PG8_LDA(At, 1, 0); PG8_STAGE(PG8_SA(0, 1), a2 + hstep, voffA);
            PG8_WAIT_L(8); PG8_BAR; PG8_WAIT_L(0); PG8_MMA(0, 0, At, B0); PG8_BAR; PG8_SCHED;
            PG8_LDB(B1, 1, 1); PG8_STAGE(PG8_SB(1, 0), b3, voffB);
            PG8_BAR; PG8_WAIT_L(0); PG8_MMA(0, 1, At, B1); PG8_BAR;
            PG8_LDA(At, 1, 1); PG8_STAGE(PG8_SA(1, 0), a3, voffA);
            PG8_BAR; PG8_WAIT_L(0); PG8_MMA(1, 0, At, B0); PG8_BAR; PG8_SCHED;
            PG8_STAGE(PG8_SB(1, 1), b3 + hstep, voffB);
            PG8_WAIT_V(6); PG8_BAR; PG8_MMA(1, 1, At, B1); PG8_BAR;
            }
        }
        if constexpr (ALIGN_EPI) { if (wr == 0) PG8_BAR; }
        E(acc, cur, wr, wc, fr, fq); S.done(cur);
        if (!has_next) break;
#pragma unroll
        for (int a = 0; a < 2; ++a)
#pragma unroll
            for (int b = 0; b < 2; ++b)
#pragma unroll
                for (int m = 0; m < 4; ++m)
#pragma unroll
                    for (int n = 0; n < 2; ++n) acc[a][b][m][n] = (f32x4){0.f, 0.f, 0.f, 0.f};
        cur = nxt; cA = nA; cB = nB; ++ui;
        if constexpr (ALIGN_EPI) { if (wr == 1) PG8_BAR; }
    }
    PG8_WAIT_V(0);
    if constexpr (!ALIGN_EPI) { if (wr == 0) PG8_BAR; }
    PG8_BAR;
#undef PG8_SA
#undef PG8_SB
#undef PG8_STAGE
#undef PG8_LDA
#undef PG8_LDB
#undef PG8_MMA
#undef PG8_WAIT_V
#undef PG8_WAIT_L
#undef PG8_BAR
#undef PG8_SCHED
}
}
constexpr int D_MODEL = 1024, BATCH = 16, SEQ = 2048, DEC_BATCH = 32, DEC_SEQ = 64, PAST = 2048;
constexpr int NH = 8, HD = 128, DK = 64, D_FF = 2816, IN_W = 7168;
constexpr int MP = BATCH * SEQ;
constexpr int MS = DEC_BATCH * DEC_SEQ;
constexpr int MT = MP + MS;
constexpr float EPS = 1e-6f;
constexpr float LOG2E = 1.4426950408889634f;
constexpr float C2 = 0.125f * LOG2E;
constexpr float LAM_INIT = 0.2f;
constexpr size_t O_YP = 0, O_YS = O_YP + (size_t)MP * 1024, O_KP = O_YS + (size_t)MS * 1024, O_VP = O_KP + (size_t)MP * 1024,
                 O_KS = O_VP + (size_t)MP * 1024, O_VS = O_KS + (size_t)MS * 1024, O_GM = O_VS + (size_t)MS * 1024, O_END = O_GM + (size_t)MS * 1024;

namespace pg8 {
__device__ __forceinline__ float fast_sigmoid(float z) { return __builtin_amdgcn_rcpf(1.0f + __builtin_amdgcn_exp2f(-z * LOG2E)); }
__device__ __forceinline__ float gelu_tanh(float x) { const float u = 1.5957691216057308f * (x + 0.044715f * x * x * x); return x * fast_sigmoid(u); }

struct EpiInProj {
    static constexpr bool PERM = true, HAS_MID = false;
    const float* r1;
    bf16_t* act0;
    float* out;
    float* gvss;
    const float *qg, *kg;
    __device__ __forceinline__ void operator()(const f32x4 (&acc)[2][2][4][2], const Unit& u, int wr, int wc, int fr, int fq) const {
        const int T = u.pn >> 2, sub = u.pn & 3;
        const int cb = sub * 256 + wc * 64 + 8 * fq;
        const int gi = 8 * fq;
        const bool samp = (u.pm >= MP / 256);
        float* kout = out + (samp ? O_KS - (size_t)MP * 1024 : O_KP);
        float* vout = out + (samp ? O_VS - (size_t)MP * 1024 : O_VP);
        bf16_t* dst = act0 + (size_t)T * ((size_t)MT * 1024);
        f32x4 gq[2][2];
#pragma unroll
        for (int bj = 0; bj < 2; ++bj)
#pragma unroll
            for (int n = 0; n < 2; ++n) gq[bj][n] = (f32x4){0.f, 0.f, 0.f, 0.f};
        if (T == 0) {
#pragma unroll
            for (int bj = 0; bj < 2; ++bj)
#pragma unroll
                for (int n = 0; n < 2; ++n) gq[bj][n] = *(const f32x4*)(qg + gi + 32 * bj + 4 * n) * C2;
        } else if (T == 1) {
#pragma unroll
            for (int bj = 0; bj < 2; ++bj)
#pragma unroll
                for (int n = 0; n < 2; ++n) gq[bj][n] = *(const f32x4*)(kg + gi + 32 * bj + 4 * n);
        }
#pragma unroll
        for (int ai = 0; ai < 2; ++ai)
#pragma unroll
            for (int m = 0; m < 4; ++m) {
                const int row = u.pm * BM + ai * HALF + wr * 64 + m * 16 + fr;
                const float rs = r1[row];
                f32x4 v[2][2];
#pragma unroll
                for (int bj = 0; bj < 2; ++bj)
#pragma unroll
                    for (int n = 0; n < 2; ++n) v[bj][n] = acc[ai][bj][m][n] * rs;
                const size_t ro = (size_t)row * 1024 + cb;
                if (T <= 1) {
                    float ss = 0.f;
#pragma unroll
                    for (int bj = 0; bj < 2; ++bj)
#pragma unroll
                        for (int n = 0; n < 2; ++n) { const f32x4 x = v[bj][n]; ss += (x[0] * x[0] + x[1] * x[1]) + (x[2] * x[2] + x[3] * x[3]); }
                    ss += __shfl_xor(ss, 16); ss += __shfl_xor(ss, 32);
                    const float rn = __builtin_amdgcn_rsqf(ss * (1.0f / 64.0f) + EPS);
#pragma unroll
                    for (int bj = 0; bj < 2; ++bj)
#pragma unroll
                        for (int n = 0; n < 2; ++n) v[bj][n] = v[bj][n] * rn * gq[bj][n];
#pragma unroll
                    for (int bj = 0; bj < 2; ++bj) { u32x4 w; w.x = cvt_pk_bf16(v[bj][0][0], v[bj][0][1]); w.y = cvt_pk_bf16(v[bj][0][2], v[bj][0][3]); w.z = cvt_pk_bf16(v[bj][1][0], v[bj][1][1]); w.w = cvt_pk_bf16(v[bj][1][2], v[bj][1][3]);
                        *(u32x4*)(dst + ro + 32 * bj) = w; }
                    if (T == 1) {
#pragma unroll
                        for (int bj = 0; bj < 2; ++bj)
#pragma unroll
                            for (int n = 0; n < 2; ++n) *(f32x4*)(kout + ro + 32 * bj + 4 * n) = v[bj][n];
                    }
                } else if (T == 2) {
#pragma unroll
                    for (int bj = 0; bj < 2; ++bj) { u32x4 w; w.x = cvt_pk_bf16(v[bj][0][0], v[bj][0][1]); w.y = cvt_pk_bf16(v[bj][0][2], v[bj][0][3]); w.z = cvt_pk_bf16(v[bj][1][0], v[bj][1][1]); w.w = cvt_pk_bf16(v[bj][1][2], v[bj][1][3]);
                        *(u32x4*)(dst + ro + 32 * bj) = w;
#pragma unroll
                        for (int n = 0; n < 2; ++n) *(f32x4*)(vout + ro + 32 * bj + 4 * n) = v[bj][n]; }
                } else if (T == 3 || T == 4) {
                    float ss = 0.f;
#pragma unroll
                    for (int bj = 0; bj < 2; ++bj)
#pragma unroll
                        for (int n = 0; n < 2; ++n)
#pragma unroll
                            for (int j = 0; j < 4; ++j) { const float gl = gelu_tanh(v[bj][n][j]); v[bj][n][j] = gl; ss += gl * gl; }
#pragma unroll
                    for (int bj = 0; bj < 2; ++bj) { u32x4 w; w.x = cvt_pk_bf16(v[bj][0][0], v[bj][0][1]); w.y = cvt_pk_bf16(v[bj][0][2], v[bj][0][3]); w.z = cvt_pk_bf16(v[bj][1][0], v[bj][1][1]); w.w = cvt_pk_bf16(v[bj][1][2], v[bj][1][3]);
                        *(u32x4*)(dst + ro + 32 * bj) = w; }
                    if (T == 4) { ss += __shfl_xor(ss, 16); ss += __shfl_xor(ss, 32); if (fq == 0) gvss[(size_t)row * 16 + sub * 4 + wc] = ss; }
                } else {
#pragma unroll
                    for (int bj = 0; bj < 2; ++bj)
#pragma unroll
                        for (int n = 0; n < 2; ++n)
#pragma unroll
                            for (int j = 0; j < 4; ++j) v[bj][n][j] = fast_sigmoid(fminf(fmaxf(v[bj][n][j], -30.f), 30.f));
#pragma unroll
                    for (int bj = 0; bj < 2; ++bj) { u32x4 w; w.x = cvt_pk_bf16(v[bj][0][0], v[bj][0][1]); w.y = cvt_pk_bf16(v[bj][0][2], v[bj][0][3]); w.z = cvt_pk_bf16(v[bj][1][0], v[bj][1][1]); w.w = cvt_pk_bf16(v[bj][1][2], v[bj][1][3]);
                        *(u32x4*)(dst + ro + 32 * bj) = w; }
                }
            }
    }
};

struct EpiMerge {
    static constexpr bool PERM = true, HAS_MID = true;
    const bf16_t *sga, *sgg; bf16_t* y1;
    __device__ __forceinline__ void mid(f32x4 (&acc)[2][2][4][2], const Unit& u, int wr, int wc, int fr, int fq) const {
        int oz; asm volatile("v_mov_b32 %0, 0" : "=v"(oz));
#pragma unroll
        for (int ai = 0; ai < 2; ++ai)
#pragma unroll
            for (int m = 0; m < 4; ++m) {
                const size_t ro = (size_t)(u.pm * BM + ai * HALF + wr * 64 + m * 16 + fr + oz) * 1024 + u.pn * BM + wc * 32 + 8 * fq;
#pragma unroll
                for (int bj = 0; bj < 2; ++bj) {
                    const u32x4 a = *(const u32x4*)(sga + ro + bj * HALF), g = *(const u32x4*)(sgg + ro + bj * HALF);
                    f32x4 r0, r1;
                    r0[0] = bf_lo(a.x) * __builtin_amdgcn_rcpf(bf_lo(g.x)); r0[1] = bf_hi(a.x) * __builtin_amdgcn_rcpf(bf_hi(g.x));
                    r0[2] = bf_lo(a.y) * __builtin_amdgcn_rcpf(bf_lo(g.y)); r0[3] = bf_hi(a.y) * __builtin_amdgcn_rcpf(bf_hi(g.y));
                    r1[0] = bf_lo(a.z) * __builtin_amdgcn_rcpf(bf_lo(g.z)); r1[1] = bf_hi(a.z) * __builtin_amdgcn_rcpf(bf_hi(g.z));
                    r1[2] = bf_lo(a.w) * __builtin_amdgcn_rcpf(bf_lo(g.w)); r1[3] = bf_hi(a.w) * __builtin_amdgcn_rcpf(bf_hi(g.w));
                    acc[ai][bj][m][0] = acc[ai][bj][m][0] * r0; acc[ai][bj][m][1] = acc[ai][bj][m][1] * r1;
                }
                asm volatile("" ::: "memory");
            }
    }
    __device__ __forceinline__ void operator()(const f32x4 (&acc)[2][2][4][2], const Unit& u, int wr, int wc, int fr, int fq) const {
#pragma unroll
        for (int ai = 0; ai < 2; ++ai)
#pragma unroll
            for (int m = 0; m < 4; ++m) {
                const size_t ro = (size_t)(u.pm * BM + ai * HALF + wr * 64 + m * 16 + fr) * 1024 + u.pn * BM + wc * 32 + 8 * fq;
#pragma unroll
                for (int bj = 0; bj < 2; ++bj) {
                    const u32x4 g = *(const u32x4*)(sgg + ro + bj * HALF);
                    const f32x4 v0 = acc[ai][bj][m][0], v1 = acc[ai][bj][m][1];
                    u32x4 w;
                    w.x = cvt_pk_bf16(v0[0] * bf_lo(g.x), v0[1] * bf_hi(g.x)); w.y = cvt_pk_bf16(v0[2] * bf_lo(g.y), v0[3] * bf_hi(g.y));
                    w.z = cvt_pk_bf16(v1[0] * bf_lo(g.z), v1[1] * bf_hi(g.z)); w.w = cvt_pk_bf16(v1[2] * bf_lo(g.w), v1[3] * bf_hi(g.w));
                    *(u32x4*)(y1 + ro + bj * HALF) = w;
                }
                asm volatile("" ::: "memory");
            }
    }
};

struct EpiOutRes {
    static constexpr bool PERM = false, HAS_MID = false;
    const float *xp, *xs; float* x1f; bf16_t* x1b; float* x1ss;
    __device__ __forceinline__ void operator()(const f32x4 (&acc)[2][2][4][2], const Unit& u, int wr, int wc, int fr, int fq) const {
        const float* xb = (u.pm >= MP / 256) ? xs - (size_t)MP * 1024 : xp;
        const int col0 = u.pn * BM + wc * 32 + 4 * fq;
#pragma unroll
        for (int ai = 0; ai < 2; ++ai)
#pragma unroll
            for (int m = 0; m < 4; ++m) {
                const int row = u.pm * BM + ai * HALF + wr * 64 + m * 16 + fr; const size_t ro = (size_t)row * 1024 + col0;
                float ss = 0.f;
#pragma unroll
                for (int bj = 0; bj < 2; ++bj)
#pragma unroll
                    for (int n = 0; n < 2; ++n) { const f32x4 x = *(const f32x4*)(xb + ro + bj * HALF + n * 16) + acc[ai][bj][m][n];
                        *(f32x4*)(x1f + ro + bj * HALF + n * 16) = x; ss += (x[0] * x[0] + x[1] * x[1]) + (x[2] * x[2] + x[3] * x[3]);
                        u32x2 w; w.x = cvt_pk_bf16(x[0], x[1]); w.y = cvt_pk_bf16(x[2], x[3]); *(u32x2*)(x1b + ro + bj * HALF + n * 16) = w; }
                ss += __shfl_xor(ss, 16); ss += __shfl_xor(ss, 32);
                if (fq == 0) x1ss[(size_t)row * 16 + u.pn * 4 + wc] = ss;
            }
    }
};

struct EpiSwiGLU {
    static constexpr bool PERM = true, HAS_MID = false;
    const float* x1ss; bf16_t* act;
    __device__ __forceinline__ void operator()(const f32x4 (&acc)[2][2][4][2], const Unit& u, int wr, int wc, int fr, int fq) const {
        const int col0 = u.pn * 128 + wc * 32 + 8 * fq;
#pragma unroll
        for (int ai = 0; ai < 2; ++ai)
#pragma unroll
            for (int m = 0; m < 4; ++m) {
                const int row = u.pm * BM + ai * HALF + wr * 64 + m * 16 + fr;
                const f32x4* sp = (const f32x4*)(x1ss + (size_t)row * 16);
                const f32x4 s0 = sp[0], s1 = sp[1], s2 = sp[2], s3 = sp[3];
                const float tot = ((s0[0] + s0[1]) + (s0[2] + s0[3])) + ((s1[0] + s1[1]) + (s1[2] + s1[3])) + ((s2[0] + s2[1]) + (s2[2] + s2[3])) + ((s3[0] + s3[1]) + (s3[2] + s3[3]));
                const float rs = __builtin_amdgcn_rsqf(tot * (1.0f / 1024.0f) + EPS);
                u32x4 w; float o[8];
#pragma unroll
                for (int n = 0; n < 2; ++n)
#pragma unroll
                    for (int j = 0; j < 4; ++j) { const float gg = acc[ai][0][m][n][j] * rs, uu = acc[ai][1][m][n][j] * rs; o[4 * n + j] = gg * fast_sigmoid(gg) * uu; }
                w.x = cvt_pk_bf16(o[0], o[1]); w.y = cvt_pk_bf16(o[2], o[3]); w.z = cvt_pk_bf16(o[4], o[5]); w.w = cvt_pk_bf16(o[6], o[7]);
                *(u32x4*)(act + (size_t)row * D_FF + col0) = w;
            }
    }
};

struct EpiFinal {
    static constexpr bool PERM = false, HAS_MID = false;
    const float* x1f; float* out;
    __device__ __forceinline__ void operator()(const f32x4 (&acc)[2][2][4][2], const Unit& u, int wr, int wc, int fr, int fq) const {
        float* ob = out + ((u.pm >= MP / 256) ? O_YS - (size_t)MP * 1024 : O_YP);
        const int col0 = u.pn * BM + wc * 32 + 4 * fq;
#pragma unroll
        for (int ai = 0; ai < 2; ++ai)
#pragma unroll
            for (int m = 0; m < 4; ++m) {
                const size_t ro = (size_t)(u.pm * BM + ai * HALF + wr * 64 + m * 16 + fr) * 1024 + col0;
#pragma unroll
                for (int bj = 0; bj < 2; ++bj)
#pragma unroll
                    for (int n = 0; n < 2; ++n) *(f32x4*)(ob + ro + bj * HALF + n * 16) = *(const f32x4*)(x1f + ro + bj * HALF + n * 16) + acc[ai][bj][m][n];
            }
    }
};
}
namespace att {
using bf16_t = unsigned short;
using bf16x8 = __attribute__((ext_vector_type(8))) short;
using s16x4  = __attribute__((ext_vector_type(4))) short;
using f32x16 = __attribute__((ext_vector_type(16))) float;
using f32x8  = __attribute__((ext_vector_type(8))) float;
using f32x4  = __attribute__((ext_vector_type(4))) float;
using u32x4  = __attribute__((ext_vector_type(4))) unsigned;
constexpr int KVBLK = 64;
constexpr int SHM_V = 16384, SHM_K = 16384;
constexpr int L_V = 0, L_K = 2 * SHM_V, L_WS = 69632, L_BT = 71680, L_END = 72704;
constexpr int XS = 132;
constexpr float THR = 8.f;
constexpr float NEGBIG = -1e30f;
#define KSWZ(row, colB) ((row) * 256 + ((colB) ^ (((row) & 7) << 4)))
#define SBAR() __builtin_amdgcn_sched_barrier(0)
__device__ __forceinline__ int crow(int r, int hi) { return (r & 3) + 8 * (r >> 2) + 4 * hi; }
__device__ __forceinline__ unsigned cvtpk(float lo, float hi) { unsigned r; asm volatile("v_cvt_pk_bf16_f32 %0, %1, %2" : "=v"(r) : "v"(lo), "v"(hi)); return r; }
template <typename TIn> struct Stage;
template <> struct Stage<bf16_t> { using T = bf16x8;
  __device__ static __forceinline__ T ld8(const bf16_t* p) { return *reinterpret_cast<const bf16x8*>(p); }
  __device__ static __forceinline__ bf16x8 tobf(T x) { return x; } };
template <> struct Stage<float> { using T = f32x8;
  __device__ static __forceinline__ T ld8(const float* p) { return *reinterpret_cast<const f32x8*>(p); }
  __device__ static __forceinline__ bf16x8 tobf(T x) {
    u32x4 w = {cvtpk(x[0], x[1]), cvtpk(x[2], x[3]), cvtpk(x[4], x[5]), cvtpk(x[6], x[7])}; return *reinterpret_cast<bf16x8*>(&w); } };

__device__ __forceinline__ void partialSM(f32x16& p0, f32x16& p1, float& m_reg, float& mn, float& alpha) {
  float pmax = p0[0];
#pragma unroll
  for (int r = 1; r < 16; ++r) pmax = fmaxf(pmax, p0[r]);
#pragma unroll
  for (int r = 0; r < 16; ++r) pmax = fmaxf(pmax, p1[r]);
  { auto rr = __builtin_amdgcn_permlane32_swap(__float_as_uint(pmax), __float_as_uint(pmax), false, false);
    pmax = fmaxf(__uint_as_float(rr[0]), __uint_as_float(rr[1])); }
  if (__builtin_expect(__all(pmax - m_reg <= THR), 1)) { mn = m_reg; alpha = 1.f; }
  else { mn = fmaxf(m_reg, pmax); alpha = __builtin_amdgcn_exp2f(m_reg - mn); m_reg = mn; }
#pragma unroll
  for (int r = 0; r < 16; ++r) p0[r] = p0[r] - mn;
#pragma unroll
  for (int r = 0; r < 16; ++r) p1[r] = p1[r] - mn;
#pragma unroll
  for (int r = 0; r < 16; ++r) p0[r] = __builtin_amdgcn_exp2f(p0[r]);
}
__device__ __forceinline__ void finishSM(f32x16& p0, f32x16& p1, float alpha, float& l_reg, bf16x8& pa0, bf16x8& pa1, bf16x8& pa2, bf16x8& pa3) {
#pragma unroll
  for (int r = 0; r < 16; ++r) p1[r] = __builtin_amdgcn_exp2f(p1[r]);
  float ps = 0;
#pragma unroll
  for (int r = 0; r < 16; ++r) ps += p0[r];
#pragma unroll
  for (int r = 0; r < 16; ++r) ps += p1[r];
  { auto rr = __builtin_amdgcn_permlane32_swap(__float_as_uint(ps), __float_as_uint(ps), false, false);
    ps = __uint_as_float(rr[0]) + __uint_as_float(rr[1]); }
  l_reg = l_reg * alpha + ps;
#define PK4(P, BASE, OUT) do { unsigned a0 = cvtpk(P[BASE + 0], P[BASE + 1]), a1 = cvtpk(P[BASE + 2], P[BASE + 3]);   \
    unsigned b0 = cvtpk(P[BASE + 4], P[BASE + 5]), b1 = cvtpk(P[BASE + 6], P[BASE + 7]);                              \
    auto r0 = __builtin_amdgcn_permlane32_swap(a0, b0, false, false); auto r1 = __builtin_amdgcn_permlane32_swap(a1, b1, false, false); \
    u32x4 w = {r0[0], r1[0], r0[1], r1[1]}; OUT = *reinterpret_cast<bf16x8*>(&w); } while (0)
  PK4(p0, 0, pa0); PK4(p0, 8, pa1); PK4(p1, 0, pa2); PK4(p1, 8, pa3);
#undef PK4
}
__device__ __forceinline__ void qkt(f32x16& p0, f32x16& p1, const char* Ks, const bf16x8* qr, int r32, int hi, int mp, float cinit) {
#pragma unroll
  for (int r = 0; r < 16; ++r) { p0[r] = cinit; p1[r] = cinit; }
#pragma unroll
  for (int d0 = 0; d0 < 4; ++d0) { const int cb = (mp * 64 + d0 * 16 + hi * 8) * 2;
    bf16x8 b0 = *reinterpret_cast<const bf16x8*>(Ks + KSWZ(r32, cb));
    bf16x8 b1 = *reinterpret_cast<const bf16x8*>(Ks + KSWZ(32 + r32, cb));
    p0 = __builtin_amdgcn_mfma_f32_32x32x16_bf16(b0, qr[d0], p0, 0, 0, 0);
    p1 = __builtin_amdgcn_mfma_f32_32x32x16_bf16(b1, qr[d0], p1, 0, 0, 0); }
}
__device__ __forceinline__ int v_st(int k, int c) { const int kk = (k & ~0xC) | ((k & 4) << 1) | ((k & 8) >> 1); return ((kk >> 3) * 4 + (c >> 5)) * 512 + ((kk & 7) * 32 + (c & 31)) * 2; }
__device__ __forceinline__ int v_rd_base(int lane) { return ((lane & 3) << 3) | (((lane >> 2) & 3) << 6) | (((lane >> 4) & 1) << 5) | (((lane >> 5) & 1) << 8); }
constexpr int v_rd_off(int d0, int ks, int half) { return d0 * 512 + ks * 4096 + half * 2048; }
template <int OFF> __device__ __forceinline__ s16x4 tr_read(int vb) {
  s16x4 r; asm volatile("ds_read_b64_tr_b16 %0, %1 offset:%2" : "=&v"(r) : "v"(vb), "i"(OFF) : "memory"); return r;
}
template <int D0> __device__ __forceinline__ void pv_one(f32x16& od, int vb, bf16x8 pa0, bf16x8 pa1, bf16x8 pa2, bf16x8 pa3) {
  const s16x4 l0 = tr_read<v_rd_off(D0, 0, 0)>(vb), h0 = tr_read<v_rd_off(D0, 0, 1)>(vb), l1 = tr_read<v_rd_off(D0, 1, 0)>(vb), h1 = tr_read<v_rd_off(D0, 1, 1)>(vb);
  const s16x4 l2 = tr_read<v_rd_off(D0, 2, 0)>(vb), h2 = tr_read<v_rd_off(D0, 2, 1)>(vb), l3 = tr_read<v_rd_off(D0, 3, 0)>(vb), h3 = tr_read<v_rd_off(D0, 3, 1)>(vb);
  asm volatile("s_waitcnt lgkmcnt(0)" ::: "memory"); SBAR();
#define PK(L, H) (bf16x8){L[0], L[1], L[2], L[3], H[0], H[1], H[2], H[3]}
  od = __builtin_amdgcn_mfma_f32_32x32x16_bf16(pa0, PK(l0, h0), od, 0, 0, 0);
  od = __builtin_amdgcn_mfma_f32_32x32x16_bf16(pa1, PK(l1, h1), od, 0, 0, 0);
  od = __builtin_amdgcn_mfma_f32_32x32x16_bf16(pa2, PK(l2, h2), od, 0, 0, 0);
  od = __builtin_amdgcn_mfma_f32_32x32x16_bf16(pa3, PK(l3, h3), od, 0, 0, 0);
#undef PK
}
__device__ __forceinline__ void pv_d0(f32x16* o, int vb, bf16x8 pa0, bf16x8 pa1, bf16x8 pa2, bf16x8 pa3) {
  pv_one<0>(o[0], vb, pa0, pa1, pa2, pa3); pv_one<1>(o[1], vb, pa0, pa1, pa2, pa3); pv_one<2>(o[2], vb, pa0, pa1, pa2, pa3); pv_one<3>(o[3], vb, pa0, pa1, pa2, pa3);
}

struct AttnArgs {
  const bf16_t *qb, *kb, *vb;
  const float *cache_k, *cache_v;
  const float *newk, *newv;
  bf16_t* ag;
  const float* bias_tab;
  const float* lamp;
  const float* subln_g;
};

template <bool SAMPLE>
__device__ __forceinline__ void attn_unit(const AttnArgs& A, int b, int h, int qt, char* lds, const int wid) {
  using TK = typename std::conditional<SAMPLE, float, bf16_t>::type;
  using St = Stage<TK>;
  const int lane = my_lane(), tid = wid * 64 + lane, r32 = lane & 31, hi = lane >> 5;
  const int rg = wid >> 1, mp = wid & 1, rge = SAMPLE ? (rg & 1) : rg;
  const int NT = SAMPLE ? 34 : 2 * qt + 2;
  const int qpos0 = (SAMPLE ? PAST : qt * 128) + 32 * rge;
  const int rowq = (SAMPLE ? MP + b * DEC_SEQ : b * SEQ + qt * 128) + 32 * rge;
  const int vis_last = SAMPLE ? 32 : 2 * qt + (rg >> 1);
  bf16_t* V_lds = (bf16_t*)(lds + L_V); bf16_t* K_lds = (bf16_t*)(lds + L_K);
  float* ws = (float*)(lds + L_WS) + wid * 64; float* li_l = ws; float* al_l = ws + 32;
  float* bt = (float*)(lds + L_BT);
  if (tid < 192) bt[tid] = A.bias_tab[h * 192 + tid];
  float m_reg = NEGBIG, l_reg = 0; f32x16 o[4];
#pragma unroll
  for (int d = 0; d < 4; ++d)
#pragma unroll
    for (int r = 0; r < 16; ++r) o[d][r] = 0.f;
  bf16x8 qr[4];
  { const bf16_t* Qw = A.qb + (size_t)(rowq + r32) * 1024 + h * 128 + mp * 64 + hi * 8;
#pragma unroll
    for (int d0 = 0; d0 < 4; ++d0) qr[d0] = *reinterpret_cast<const bf16x8*>(Qw + d0 * 16); }
  const int sr = tid >> 4, sc = (tid & 15) * 8, vst0 = v_st(sr, sc), vst1 = v_st(32 + sr, sc);
  const int vb0 = (int)(uintptr_t)V_lds + v_rd_base(lane);
  const TK *kbase, *vbase;
  if constexpr (SAMPLE) { kbase = A.cache_k + (size_t)b * PAST * 1024 + h * 128; vbase = A.cache_v + (size_t)b * PAST * 1024 + h * 128; }
  else { kbase = (const TK*)A.kb + (size_t)b * SEQ * 1024 + h * 128; vbase = (const TK*)A.vb + (size_t)b * SEQ * 1024 + h * 128; }
  const float* nk = A.newk + (size_t)b * DEC_SEQ * 1024 + h * 128; const float* nv = A.newv + (size_t)b * DEC_SEQ * 1024 + h * 128;
  struct { typename St::T vs0, vs1, ks0, ks1; } sg;
#define KSRC(t) (SAMPLE ? (((t) < 32) ? (const TK*)(kbase + (size_t)(t) * KVBLK * 1024) : (const TK*)nk) : (const TK*)(kbase + (size_t)(t) * KVBLK * 1024))
#define VSRC(t) (SAMPLE ? (((t) < 32) ? (const TK*)(vbase + (size_t)(t) * KVBLK * 1024) : (const TK*)nv) : (const TK*)(vbase + (size_t)(t) * KVBLK * 1024))
#define SLOAD(t) do { const TK* kp_ = KSRC(t); const TK* vp_ = VSRC(t); \
    sg.vs0 = St::ld8(vp_ + (size_t)sr * 1024 + sc); sg.vs1 = St::ld8(vp_ + (size_t)(32 + sr) * 1024 + sc); \
    sg.ks0 = St::ld8(kp_ + (size_t)sr * 1024 + sc); sg.ks1 = St::ld8(kp_ + (size_t)(32 + sr) * 1024 + sc); } while (0)
#define SWRITE(bf) do { *(bf16x8*)((char*)V_lds + (bf) * SHM_V + vst0) = St::tobf(sg.vs0);          \
    *(bf16x8*)((char*)V_lds + (bf) * SHM_V + vst1) = St::tobf(sg.vs1); const int kc = sc * 2;               \
    *(bf16x8*)((char*)K_lds + (bf) * SHM_K + KSWZ(sr, kc)) = St::tobf(sg.ks0);                       \
    *(bf16x8*)((char*)K_lds + (bf) * SHM_K + KSWZ(32 + sr, kc)) = St::tobf(sg.ks1); } while (0)
#define RESC(a) do { if (__any((a) < 1.f)) { if (hi == 0) al_l[r32] = (a); asm volatile("s_waitcnt lgkmcnt(0)" ::: "memory"); \
    _Pragma("unroll") for (int d = 0; d < 4; ++d) _Pragma("unroll") for (int r = 0; r < 16; ++r) o[d][r] *= al_l[crow(r, hi)]; } } while (0)
#define T_MASKED(t) ((t) > vis_last)
#define T_FAR(t) (64 * (t) + 63 - qpos0 <= -91)
#define CINIT(t) ((!T_MASKED(t) && T_FAR(t)) ? bt0 : 0.f)
#define FIX(P0, P1, t) do { if (T_MASKED(t)) { _Pragma("unroll") for (int r = 0; r < 16; ++r) { P0[r] = NEGBIG; P1[r] = NEGBIG; } } \
    else if (!T_FAR(t)) { const int db_ = 64 * (t) - (qpos0 + r32) + 127; \
      _Pragma("unroll") for (int r = 0; r < 16; ++r) { const int i0_ = db_ + crow(r, hi); P0[r] += bt[i0_ < 0 ? 0 : i0_]; const int i1_ = i0_ + 32; P1[r] += bt[i1_ < 0 ? 0 : i1_]; } } } while (0)
  f32x16 pA0, pA1, pB0, pB1; float mnA, mnB, alA, alB; bf16x8 pa0, pa1, pa2, pa3;
  SLOAD(0); asm volatile("s_waitcnt vmcnt(0)" ::: "memory"); SWRITE(0); __syncthreads();
  const float bt0 = bt[0];
  qkt(pA0, pA1, (const char*)K_lds, qr, r32, hi, mp, CINIT(0)); FIX(pA0, pA1, 0); partialSM(pA0, pA1, m_reg, mnA, alA);
  SLOAD(1); asm volatile("s_waitcnt vmcnt(0)" ::: "memory"); SWRITE(1); __syncthreads();
  for (int j = 1; j + 1 < NT; j += 2) {
    SBAR(); qkt(pB0, pB1, (const char*)K_lds + SHM_K, qr, r32, hi, mp, CINIT(j)); FIX(pB0, pB1, j);
    finishSM(pA0, pA1, alA, l_reg, pa0, pa1, pa2, pa3); SBAR();
    SLOAD(j + 1); SBAR();
    pv_d0(o, vb0, pa0, pa1, pa2, pa3); partialSM(pB0, pB1, m_reg, mnB, alB);
    __syncthreads(); asm volatile("s_waitcnt vmcnt(0)" ::: "memory"); SWRITE(0);
    RESC(alB); __syncthreads();
    SBAR(); qkt(pA0, pA1, (const char*)K_lds, qr, r32, hi, mp, CINIT(j + 1)); FIX(pA0, pA1, j + 1);
    finishSM(pB0, pB1, alB, l_reg, pa0, pa1, pa2, pa3); SBAR();
    { const int tn = (j + 2 < NT) ? j + 2 : NT - 1; SLOAD(tn); } SBAR();
    pv_d0(o, vb0 + SHM_V, pa0, pa1, pa2, pa3); partialSM(pA0, pA1, m_reg, mnA, alA);
    __syncthreads(); asm volatile("s_waitcnt vmcnt(0)" ::: "memory"); SWRITE(1);
    RESC(alA); __syncthreads();
  }
  SBAR(); qkt(pB0, pB1, (const char*)K_lds + SHM_K, qr, r32, hi, mp, CINIT(NT - 1)); FIX(pB0, pB1, NT - 1);
  finishSM(pA0, pA1, alA, l_reg, pa0, pa1, pa2, pa3); SBAR();
  pv_d0(o, vb0, pa0, pa1, pa2, pa3); partialSM(pB0, pB1, m_reg, mnB, alB);
  __syncthreads(); RESC(alB);
  finishSM(pB0, pB1, alB, l_reg, pa0, pa1, pa2, pa3); SBAR();
  pv_d0(o, vb0 + SHM_V, pa0, pa1, pa2, pa3);
  if (hi == 0) li_l[r32] = l_reg; asm volatile("s_waitcnt lgkmcnt(0)" ::: "memory");
  const float lamv = mp ? A.lamp[0] : 1.f;
  float sc16[16];
#pragma unroll
  for (int r = 0; r < 16; ++r) sc16[r] = __builtin_amdgcn_rcpf(li_l[crow(r, hi)]) * lamv;
  __syncthreads();
  float* X = (float*)lds + rg * (32 * XS);
  if (mp == 1) {
#pragma unroll
    for (int r = 0; r < 16; ++r)
#pragma unroll
      for (int d0 = 0; d0 < 4; ++d0) X[crow(r, hi) * XS + d0 * 32 + r32] = o[d0][r] * sc16[r];
  }
  __syncthreads();
  if (mp == 0) {
#pragma unroll
    for (int r = 0; r < 16; ++r)
#pragma unroll
      for (int d0 = 0; d0 < 4; ++d0) { const int ix = crow(r, hi) * XS + d0 * 32 + r32; X[ix] = o[d0][r] * sc16[r] - X[ix]; }
    asm volatile("s_waitcnt lgkmcnt(0)" ::: "memory");
    const int row = lane >> 1, half = lane & 1;
    const f32x4* xr = (const f32x4*)(X + row * XS + 64 * half);
    f32x4 xv[16]; float ss = 0.f;
#pragma unroll
    for (int i = 0; i < 16; ++i) { xv[i] = xr[i]; ss += (xv[i][0] * xv[i][0] + xv[i][1] * xv[i][1]) + (xv[i][2] * xv[i][2] + xv[i][3] * xv[i][3]); }
    ss += __shfl_xor(ss, 1);
    const float rn = __builtin_amdgcn_rsqf(ss * (1.0f / 128.0f) + EPS) * (1.0f - LAM_INIT);
    if (!SAMPLE || rg < 2) {
      bf16_t* op = A.ag + (size_t)(rowq + row) * 2048 + h * 128 + 64 * half;
      const f32x4* gp = (const f32x4*)(A.subln_g + 64 * half);
#pragma unroll
      for (int i = 0; i < 8; ++i) { const f32x4 g0 = gp[2 * i], g1 = gp[2 * i + 1]; const f32x4 a0 = xv[2 * i] * g0 * rn, a1 = xv[2 * i + 1] * g1 * rn;
        u32x4 w = {cvtpk(a0[0], a0[1]), cvtpk(a0[2], a0[3]), cvtpk(a1[0], a1[1]), cvtpk(a1[2], a1[3])}; *(u32x4*)(op + 8 * i) = w; }
    }
  }
  __syncthreads();
#undef KSRC
#undef VSRC
#undef SLOAD
#undef SWRITE
#undef RESC
#undef T_MASKED
#undef T_FAR
#undef CINIT
#undef FIX
}

struct SguArgs {
  const bf16_t *gub, *gvb;
  const float* gvss;
  const bf16_t* wm;
  const float *gn, *gmb;
  bf16_t* ag;
  float* out;
};
constexpr int SG_WM = 0, SG_GT = 34816, SG_RS = 69632, SG_STR = 136;
__device__ __forceinline__ void sgu_item(const SguArgs& S, int row0, int g, bool samp, char* lds, const int wid) {
  const int lane = my_lane(), tid = wid * 64 + lane, r32 = lane & 31, hi = lane >> 5;
  const int T = samp ? 64 : 128;
  bf16_t* wmL = (bf16_t*)(lds + SG_WM); bf16_t* gvT = (bf16_t*)(lds + SG_GT); float* rsL = (float*)(lds + SG_RS);
  if (tid < 128) { float r = 0.f;
    if (tid < T) { const f32x4* sp = (const f32x4*)(S.gvss + (size_t)(row0 + tid) * 16); const f32x4 s0 = sp[0], s1 = sp[1], s2 = sp[2], s3 = sp[3];
      const float tot = ((s0[0] + s0[1]) + (s0[2] + s0[3])) + ((s1[0] + s1[1]) + (s1[2] + s1[3])) + ((s2[0] + s2[1]) + (s2[2] + s2[3])) + ((s3[0] + s3[1]) + (s3[2] + s3[3]));
      r = __builtin_amdgcn_rsqf(tot * (1.0f / 1024.0f) + EPS); }
    rsL[tid] = r; }
#pragma unroll
  for (int i = 0; i < 4; ++i) { const int ch = tid + 512 * i, rw = ch >> 4, c8 = (ch & 15) * 8;
    *(u32x4*)(wmL + rw * SG_STR + c8) = *(const u32x4*)(S.wm + (size_t)g * 16384 + rw * 128 + c8); }
  __syncthreads();
#pragma unroll 1
  for (int i = 0; i < 4; ++i) { const int ch = tid + 512 * i, s = ch >> 4, cc = (ch & 15) * 8;
    u32x4 x = {0u, 0u, 0u, 0u};
    if (s < T) x = *(const u32x4*)(S.gvb + (size_t)(row0 + s) * 1024 + g * 128 + cc);
    const float r = rsL[s];
    float f[8] = {__uint_as_float(x.x << 16) * r, __uint_as_float(x.x & 0xffff0000u) * r, __uint_as_float(x.y << 16) * r, __uint_as_float(x.y & 0xffff0000u) * r,
                  __uint_as_float(x.z << 16) * r, __uint_as_float(x.z & 0xffff0000u) * r, __uint_as_float(x.w << 16) * r, __uint_as_float(x.w & 0xffff0000u) * r};
#pragma unroll
    for (int j = 0; j < 8; j += 2) { const unsigned w = cvtpk(f[j], f[j + 1]); gvT[(cc + j) * SG_STR + s] = (bf16_t)(w & 0xffffu); gvT[(cc + j + 1) * SG_STR + s] = (bf16_t)(w >> 16); }
    if (samp && s < T) { const f32x4* gp = (const f32x4*)(S.gn + g * 128 + cc); const f32x4 g0 = gp[0], g1 = gp[1];
      float* op = S.out + O_GM + (size_t)(row0 - MP + s) * 1024 + g * 128 + cc;
      *(f32x4*)op = (f32x4){f[0] * g0[0], f[1] * g0[1], f[2] * g0[2], f[3] * g0[3]}; *(f32x4*)(op + 4) = (f32x4){f[4] * g1[0], f[5] * g1[1], f[6] * g1[2], f[7] * g1[3]}; }
  }
  __syncthreads();
  const int tb = wid >> 1, cbp = wid & 1;
  if (32 * tb < T) {
    f32x16 acc[2];
#pragma unroll
    for (int c = 0; c < 2; ++c)
#pragma unroll
      for (int r = 0; r < 16; ++r) acc[c][r] = 0.f;
    for (int ks = 0; ks <= 2 * tb + 1; ++ks) {
      const bf16x8 a = *(const bf16x8*)(wmL + (32 * tb + r32) * SG_STR + 16 * ks + 8 * hi);
#pragma unroll
      for (int c = 0; c < 2; ++c) { const bf16x8 bfr = *(const bf16x8*)(gvT + (32 * (2 * cbp + c) + r32) * SG_STR + 16 * ks + 8 * hi);
        acc[c] = __builtin_amdgcn_mfma_f32_32x32x16_bf16(a, bfr, acc[c], 0, 0, 0); }
    }
#pragma unroll
    for (int c = 0; c < 2; ++c) { const int col = g * 128 + 32 * (2 * cbp + c) + r32; const float gnc = S.gn[col];
#pragma unroll
      for (int r = 0; r < 16; ++r) { const int t = 32 * tb + crow(r, hi); const size_t grow = (size_t)(row0 + t);
        const float z = acc[c][r] * gnc + S.gmb[g * 128 + t];
        const float gu = __uint_as_float((unsigned)S.gub[grow * 1024 + col] << 16);
        const unsigned w = cvtpk(gu * z, 0.f); S.ag[grow * 2048 + 1024 + col] = (bf16_t)(w & 0xffffu); } }
  }
  __syncthreads();
}
#undef KSWZ
#undef SBAR
}
#define LAS __attribute__((address_space(3)))
typedef unsigned short bf16;
typedef unsigned v4u __attribute__((ext_vector_type(4)));
typedef float f32x4 __attribute__((ext_vector_type(4)));
constexpr int NWAVES = 8;
constexpr int LDS_BYTES = 131072;
constexpr size_t MiB = 1u << 20;
constexpr size_t SZ_ACT = (size_t)MT * 1024 * 2;
constexpr size_t WS_BT1 = 0;
constexpr size_t WS_BT3 = WS_BT1 + (size_t)IN_W * 1024 * 2;
constexpr size_t WS_BT4 = WS_BT3 + (size_t)1024 * 2048 * 2;
constexpr size_t WS_BT5 = WS_BT4 + (size_t)1024 * 1024 * 2;
constexpr size_t WS_BT6 = WS_BT5 + (size_t)2 * D_FF * 1024 * 2;
constexpr size_t WS_WM  = WS_BT6 + (size_t)1024 * D_FF * 2;
constexpr size_t WS_MISC = WS_WM + (size_t)8 * 128 * 128 * 2;
constexpr size_t WS_R1  = WS_MISC + 8192;
constexpr size_t WS_GVSS = WS_R1 + (size_t)MT * 4;
constexpr size_t WS_X1SS = WS_GVSS + (size_t)MT * 64;
constexpr size_t WS_XB  = ((WS_X1SS + (size_t)MT * 64 + 4095) / 4096) * 4096;
constexpr size_t WS_Q   = WS_XB + SZ_ACT;
constexpr size_t WS_K   = WS_Q + SZ_ACT, WS_V = WS_K + SZ_ACT, WS_GU = WS_V + SZ_ACT, WS_GV = WS_GU + SZ_ACT;
constexpr size_t WS_SGA = WS_GV + SZ_ACT, WS_SGG = WS_SGA + SZ_ACT;
constexpr size_t WS_AG  = WS_SGG + SZ_ACT;
constexpr size_t WS_X1F = WS_AG + 2 * SZ_ACT;
constexpr size_t WS_END = WS_X1F + 2 * SZ_ACT;
static_assert((size_t)MT * D_FF * 2 <= 5 * SZ_ACT, "act overlays q..gv");

struct Args {
    const float *x_prompt, *x_sample, *cache_k, *cache_v, *rel_table, *norm1_g, *w_in, *q_norm_g, *k_norm_g, *lq1, *lk1, *lq2, *lk2, *subln_g, *gm_norm_g, *gm_w_s, *gm_b,
                *w_ab, *w_gb, *w_out, *norm2_g, *w_ffn_in, *w_ffn_out;
    float* out; unsigned char* ws; int ph_lo, ph_hi;
};

__device__ __forceinline__ unsigned f2bf(float f) { unsigned u = __builtin_bit_cast(unsigned, f); return (u + 0x7fffu + ((u >> 16) & 1u)) >> 16; }
__device__ __forceinline__ unsigned pk2(float lo, float hi) { return f2bf(lo) | (f2bf(hi) << 16); }
__device__ __forceinline__ float wave_sum(float v) {
#pragma unroll
    for (int o = 1; o < 64; o <<= 1) v += __shfl_xor(v, o);
    return v;
}
__device__ __forceinline__ void p0_transpose_item(const float* W, int N, int k0, int n0, bf16* WT, int ldt, int orow0, int koff, const float* scale, LAS float* scr, int lane) {
#pragma unroll 8
    for (int i = 0; i < 32; ++i) { const int kk = 2 * i + (lane >> 5); const float s = scale ? scale[k0 + kk] : 1.f; scr[kk * 33 + (lane & 31)] = W[(size_t)(k0 + kk) * N + n0 + (lane & 31)] * s; }
    asm volatile("s_waitcnt lgkmcnt(0)" ::: "memory");
    const int c = lane & 7;
#pragma unroll
    for (int j = 0; j < 4; ++j) { const int n = (lane >> 3) + 8 * j; const LAS float* s = scr + (8 * c) * 33 + n;
        v4u o; o.x = pk2(s[0 * 33], s[1 * 33]); o.y = pk2(s[2 * 33], s[3 * 33]); o.z = pk2(s[4 * 33], s[5 * 33]); o.w = pk2(s[6 * 33], s[7 * 33]);
        *(v4u*)(WT + (size_t)(orow0 + n) * ldt + koff + k0 + 8 * c) = o; }
    asm volatile("s_waitcnt lgkmcnt(0)" ::: "memory");
}
__device__ __forceinline__ int rel_bucket(int rel) {
    const int n = rel < 0 ? -rel : rel; int bk;
    if (n < 8) bk = n; else if (n < 12) bk = 8; else if (n < 16) bk = 9; else if (n < 23) bk = 10; else if (n < 32) bk = 11; else if (n < 46) bk = 12; else if (n < 64) bk = 13; else if (n < 91) bk = 14; else bk = 15;
    return (rel > 0 ? 16 : 0) + bk;
}

__device__ __forceinline__ void p0_prologue(const Args& a, LAS unsigned char* lds, int vcu, int G, const int wave) {
    unsigned char* ws = a.ws;
    const int lane = my_lane(), tid = wave * 64 + lane, gw = vcu * NWAVES + wave, NGW = G * NWAVES;
    LAS float* scr = (LAS float*)(lds + wave * 16384);
    constexpr int I1 = 16 * (IN_W / 32), I3 = 16 * 32, I5 = 16 * (2 * D_FF / 32), I6 = (D_FF / 64) * 32;
    constexpr int NITEMS = I1 + 3 * I3 + I5 + I6;
    for (int it = gw; it < NITEMS; it += NGW) {
        int r = it;
        if (r < I1) { const int nb = IN_W / 32, kb = r / nb, n0 = (r % nb) * 32, tile = n0 >> 8, L = n0 & 255, P = 128 * ((L >> 5) & 1) + 32 * (L >> 6);
            p0_transpose_item(a.w_in, IN_W, 64 * kb, n0, (bf16*)(ws + WS_BT1), 1024, tile * 256 + P, 0, a.norm1_g, scr, lane); continue; } r -= I1;
        if (r < I3) { const int kb = r / 32, n0 = (r % 32) * 32; p0_transpose_item(a.w_ab, 1024, 64 * kb, n0, (bf16*)(ws + WS_BT3), 2048, n0, 0, nullptr, scr, lane); continue; } r -= I3;
        if (r < I3) { const int kb = r / 32, n0 = (r % 32) * 32; p0_transpose_item(a.w_gb, 1024, 64 * kb, n0, (bf16*)(ws + WS_BT3), 2048, n0, 1024, nullptr, scr, lane); continue; } r -= I3;
        if (r < I3) { const int kb = r / 32, n0 = (r % 32) * 32; p0_transpose_item(a.w_out, 1024, 64 * kb, n0, (bf16*)(ws + WS_BT4), 1024, n0, 0, nullptr, scr, lane); continue; } r -= I3;
        if (r < I5) { const int nb = 2 * D_FF / 32, kb = r / nb, n0 = (r % nb) * 32, half = n0 >= D_FF ? 1 : 0, jh = n0 - half * D_FF, orow = (jh >> 7) * 256 + 128 * half + (jh & 127);
            p0_transpose_item(a.w_ffn_in, 2 * D_FF, 64 * kb, n0, (bf16*)(ws + WS_BT5), 1024, orow, 0, a.norm2_g, scr, lane); continue; } r -= I5;
        { const int kb = r / 32, n0 = (r % 32) * 32; p0_transpose_item(a.w_ffn_out, 1024, 64 * kb, n0, (bf16*)(ws + WS_BT6), D_FF, n0, 0, nullptr, scr, lane); }
    }
    for (int i = gw * 64 + lane; i < 8 * 128 * 128 / 4; i += NGW * 64) { const int e = i * 4, t = (e >> 7) & 127, s = e & 127; const f32x4 w = *(const f32x4*)(a.gm_w_s + e);
        const unsigned lo = pk2(s <= t ? w[0] : 0.f, s + 1 <= t ? w[1] : 0.f), hi = pk2(s + 2 <= t ? w[2] : 0.f, s + 3 <= t ? w[3] : 0.f);
        *(unsigned long long*)((bf16*)(ws + WS_WM) + e) = (unsigned long long)lo | ((unsigned long long)hi << 32); }
    for (int m = gw; m < MT; m += NGW) {
        const float* xrow = (m < MP) ? a.x_prompt + (size_t)m * 1024 : a.x_sample + (size_t)(m - MP) * 1024;
        const f32x4* xr = (const f32x4*)xrow + lane; f32x4 v[4]; float s = 0.f;
#pragma unroll
        for (int j = 0; j < 4; ++j) { v[j] = xr[64 * j]; s += (v[j][0] * v[j][0] + v[j][1] * v[j][1]) + (v[j][2] * v[j][2] + v[j][3] * v[j][3]); }
        s = wave_sum(s);
        if (lane == 0) ((float*)(ws + WS_R1))[m] = __builtin_amdgcn_rsqf(s * (1.0f / 1024.0f) + EPS);
        unsigned long long* o8 = (unsigned long long*)((bf16*)(ws + WS_XB) + (size_t)m * 1024) + lane;
#pragma unroll
        for (int j = 0; j < 4; ++j) o8[64 * j] = (unsigned long long)pk2(v[j][0], v[j][1]) | ((unsigned long long)pk2(v[j][2], v[j][3]) << 32);
    }
    if (blockIdx.x == 0) {
        float* misc = (float*)(ws + WS_MISC);
        for (int i = tid; i < 8 * 192; i += NWAVES * 64) { const int h = i / 192, idx = i % 192, rel = idx - 127;
            misc[i] = (idx < 191) ? a.rel_table[rel_bucket(rel) * 8 + h] * LOG2E : 0.f; }
        if (wave == 0) { const float s1 = wave_sum(a.lq1[lane] * a.lk1[lane]), s2 = wave_sum(a.lq2[lane] * a.lk2[lane]);
            if (lane == 0) misc[8 * 192] = __expf(s1) - __expf(s2) + LAM_INIT; }
    }
}

__global__ void __launch_bounds__(NWAVES * 64, 2) fwd_megakernel(Args args) {
    extern __shared__ __attribute__((aligned(16))) unsigned char lds[];
    cg::grid_group grid = cg::this_grid();
    LAS unsigned char* ldsl = (LAS unsigned char*)lds;
    const int wave = __builtin_amdgcn_readfirstlane(threadIdx.x >> 6);
    const int G = gridDim.x, bx = blockIdx.x, vcu = (G % 8 == 0) ? (bx % 8) * (G / 8) + bx / 8 : bx;
    unsigned char* ws = args.ws;
    const int lo = args.ph_lo, hi = args.ph_hi;
#define IN(k) (lo <= (k) && (k) < hi)
#define SEAM(k) do { if (IN(k) && IN((k) + 1)) grid.sync(); } while (0)
    if (IN(0)) { p0_prologue(args, ldsl, vcu, G, wave); __syncthreads(); }
    SEAM(0);
    if (IN(1)) {
        pg8::Gemm g{(const bf16*)(ws + WS_XB), (const bf16*)(ws + WS_BT1), MT, IN_W, 1024}; pg8::StaticOrder S; S.init(MT, IN_W, G, bx);
        pg8::EpiInProj E{(const float*)(ws + WS_R1), (bf16*)(ws + WS_Q),
                         args.out, (float*)(ws + WS_GVSS), args.q_norm_g, args.k_norm_g};
        pg8::gemm_phase<pg8::EpiInProj, pg8::StaticOrder, true, true>(ldsl, g, S, E, wave);
    }
    SEAM(1);
    if (IN(2)) {
        const float* misc = (const float*)(ws + WS_MISC);
        att::AttnArgs A{(const bf16*)(ws + WS_Q), (const bf16*)(ws + WS_K), (const bf16*)(ws + WS_V), args.cache_k, args.cache_v, args.out + O_KS, args.out + O_VS,
                        (bf16*)(ws + WS_AG), misc, misc + 8 * 192, args.subln_g};
        for (int u = vcu; u < DEC_BATCH * NH; u += G) att::attn_unit<true>(A, u >> 3, u & 7, 0, (char*)lds, wave);
        for (int w = vcu; w < BATCH * NH * 2; w += G) { const int bh = w >> 1, s0 = 4 * (w & 1);
            for (int i = 0; i < 4; ++i) { att::attn_unit<false>(A, bh >> 3, bh & 7, s0 + i, (char*)lds, wave); att::attn_unit<false>(A, bh >> 3, bh & 7, 15 - (s0 + i), (char*)lds, wave); } }
        att::SguArgs SG{(const bf16*)(ws + WS_GU), (const bf16*)(ws + WS_GV), (const float*)(ws + WS_GVSS), (const bf16*)(ws + WS_WM), args.gm_norm_g, args.gm_b, (bf16*)(ws + WS_AG), args.out};
        for (int it = vcu; it < (MP / 128) * 8 + DEC_BATCH * 8; it += G) {
            if (it < (MP / 128) * 8) att::sgu_item(SG, (it >> 3) * 128, it & 7, false, (char*)lds, wave);
            else { const int r = it - (MP / 128) * 8; att::sgu_item(SG, MP + (r >> 3) * 64, r & 7, true, (char*)lds, wave); }
        }
    }
    SEAM(2);
    if (IN(3)) {
        pg8::Gemm g{(const bf16*)(ws + WS_AG), (const bf16*)(ws + WS_BT3), MT, 1024, 2048}; pg8::StaticOrder S; S.init(MT, 1024, G, bx);
        pg8::EpiMerge E{(const bf16*)(ws + WS_SGA), (const bf16*)(ws + WS_SGG), (bf16*)(ws + WS_XB)};
        pg8::gemm_phase<pg8::EpiMerge, pg8::StaticOrder, true, true>(ldsl, g, S, E, wave);
    }
    SEAM(3);
    if (IN(4)) {
        pg8::Gemm g{(const bf16*)(ws + WS_XB), (const bf16*)(ws + WS_BT4), MT, 1024, 1024}; pg8::StaticOrder S; S.init(MT, 1024, G, bx);
        pg8::EpiOutRes E{args.x_prompt, args.x_sample, (float*)(ws + WS_X1F), (bf16*)(ws + WS_AG), (float*)(ws + WS_X1SS)};
        pg8::gemm_phase<pg8::EpiOutRes, pg8::StaticOrder, true, true>(ldsl, g, S, E, wave);
    }
    SEAM(4);
    if (IN(5)) {
        pg8::Gemm g{(const bf16*)(ws + WS_AG), (const bf16*)(ws + WS_BT5), MT, 2 * D_FF, 1024}; pg8::StaticOrder S; S.init(MT, 2 * D_FF, G, bx);
        pg8::EpiSwiGLU E{(const float*)(ws + WS_X1SS), (bf16*)(ws + WS_Q)};
        pg8::gemm_phase<pg8::EpiSwiGLU, pg8::StaticOrder, true, true>(ldsl, g, S, E, wave);
    }
    SEAM(5);
    if (IN(6)) {
        pg8::Gemm g{(const bf16*)(ws + WS_Q), (const bf16*)(ws + WS_BT6), MT, 1024, D_FF}; pg8::StaticOrder S; S.init(MT, 1024, G, bx);
        pg8::EpiFinal E{(const float*)(ws + WS_X1F), args.out};
        pg8::gemm_phase<pg8::EpiFinal, pg8::StaticOrder, true, true>(ldsl, g, S, E, wave);
    }
#undef IN
#undef SEAM
}

#ifndef MK_N_LAUNCHES
#define MK_N_LAUNCHES 1
#endif
extern "C" void kernel_launch(void* const* d_in, const int* in_sizes, int n_in, void* d_out, int out_size, void* d_ws, size_t ws_size, hipStream_t stream) {
    static int grid = 0;
    if (grid == 0) {
        if (n_in != 23 || (size_t)out_size != O_END || ws_size < WS_END) { fprintf(stderr, "kernel_launch: unexpected shapes: n_in %d out %d ws %zu (need %zu)\n", n_in, out_size, ws_size, (size_t)WS_END); grid = -1; return; }
        int dev = 0, cus = 0, per_cu = 0;
        if (hipGetDevice(&dev) != hipSuccess || hipDeviceGetAttribute(&cus, hipDeviceAttributeMultiprocessorCount, dev) != hipSuccess) { grid = -1; return; }
        if (hipFuncSetAttribute((const void*)fwd_megakernel, hipFuncAttributeMaxDynamicSharedMemorySize, LDS_BYTES) != hipSuccess) { fprintf(stderr, "kernel_launch: hipFuncSetAttribute failed\n"); grid = -1; return; }
        if (hipOccupancyMaxActiveBlocksPerMultiprocessor(&per_cu, (const void*)fwd_megakernel, NWAVES * 64, LDS_BYTES) != hipSuccess || per_cu < 1) { fprintf(stderr, "kernel_launch: occupancy query says %d\n", per_cu); grid = -1; return; }
        grid = cus;
    }
    if (grid < 0) return;
    Args a{};
    const float** p = (const float**)&a;
    for (int i = 0; i < 23; ++i) p[i] = (const float*)d_in[i];
    a.out = (float*)d_out; a.ws = (unsigned char*)d_ws;
#if MK_N_LAUNCHES == 1
    a.ph_lo = 0; a.ph_hi = 7;
    void* kargs[] = {&a};
    hipError_t e = hipLaunchCooperativeKernel((const void*)fwd_megakernel, dim3(grid), dim3(NWAVES * 64), kargs, LDS_BYTES, stream);
    if (e != hipSuccess) fprintf(stderr, "cooperative launch failed: %s (grid %d)\n", hipGetErrorString(e), grid);
#else
    for (int ph = 0; ph < 7; ++ph) { a.ph_lo = ph; a.ph_hi = ph + 1;
        void* kargs[] = {&a};
        hipError_t e = hipLaunchCooperativeKernel((const void*)fwd_megakernel, dim3(grid), dim3(NWAVES * 64), kargs, LDS_BYTES, stream);
        if (e != hipSuccess) { fprintf(stderr, "launch %d failed: %s (grid %d)\n", ph, hipGetErrorString(e), grid); break; } }
#endif
}
```

```cpp
#include <hip/hip_runtime.h>
#include <hip/hip_cooperative_groups.h>
#include <cstdio>
#include <cstdint>
#include <type_traits>
namespace cg = cooperative_groups;
__device__ __forceinline__ int my_lane() { int l; asm volatile("v_mbcnt_lo_u32_b32 %0, -1, 0\n\tv_mbcnt_hi_u32_b32 %0, -1, %0" : "=v"(l)); return l; }
#define LAS __attribute__((address_space(3)))
#define XB_TMO      128
#define XB_XCNT(j)  (256  + 64 * (j))
#define XB_XSUB(j)  (1280 + 64 * (j))
#define XB_XGEN(j)  (2304 + 64 * (j))
#define XB_TOP      3328
#define XB_TOPGEN   3392
#define XCD_BAR_WORDS 3456
#define XB_SPIN_CAP (1u << 18)

__device__ __forceinline__ unsigned xb_ld(unsigned* p)              { return __hip_atomic_load(p, __ATOMIC_RELAXED, __HIP_MEMORY_SCOPE_AGENT); }
__device__ __forceinline__ unsigned xb_add(unsigned* p, unsigned v) { return __hip_atomic_fetch_add(p, v, __ATOMIC_RELAXED, __HIP_MEMORY_SCOPE_AGENT); }
__device__ __forceinline__ unsigned xb_xcc_id() { return (unsigned)__builtin_amdgcn_s_getreg((3 << 11) | 20) & 0xFu; }
#define XB_SPIN(cond, bar) do { unsigned _sp = 0; while (cond) { __builtin_amdgcn_s_sleep(1); \
    if ((++_sp & 255u) == 0u) { if (xb_ld(&(bar)[XB_TMO])) break; if (_sp > XB_SPIN_CAP) { atomicAdd(&(bar)[XB_TMO], 1u); break; } } } } while (0)

struct XcdBarrier {
    unsigned* bar; unsigned x;
    volatile LAS unsigned* st;
};

__device__ __forceinline__ XcdBarrier xcd_barrier_post(unsigned* bar, volatile LAS unsigned* st) {
    XcdBarrier b; b.bar = bar; b.x = xb_xcc_id(); b.st = st;
    if (threadIdx.x == 0) (void)xb_add(&bar[XB_XCNT(b.x)], 1u);
    return b;
}
__device__ __forceinline__ void xcd_barrier_complete(unsigned* bar, unsigned x, unsigned& nloc, unsigned& nx) {
    const unsigned G = gridDim.x * gridDim.y * gridDim.z;
    unsigned sum, cnt, mine, sp = 0u;
    for (;;) {
        sum = 0u; cnt = 0u; mine = 0u;
#pragma unroll
        for (unsigned j = 0; j < 16; ++j) { const unsigned c = xb_ld(&bar[XB_XCNT(j)]); sum += c; cnt += (c > 0u) ? 1u : 0u; mine = (j == x) ? c : mine; }
        if (sum == G) break;
        __builtin_amdgcn_s_sleep(1);
        if ((++sp & 255u) == 0u) { if (xb_ld(&bar[XB_TMO])) break; if (sp > XB_SPIN_CAP) { atomicAdd(&bar[XB_TMO], 1u); break; } }
    }
    nloc = mine > 0u ? mine : 1u; nx = cnt > 0u ? cnt : 1u;
}

__device__ __forceinline__ void xcd_barrier(const XcdBarrier& b) {
    asm volatile("s_waitcnt vmcnt(0)" ::: "memory");
    __syncthreads();
    if (threadIdx.x == 0) {
        unsigned* bar = b.bar;
        __builtin_amdgcn_s_waitcnt(0);
        unsigned nloc = b.st[0], nx = b.st[1];
        if (nloc == 0u) { xcd_barrier_complete(bar, b.x, nloc, nx); b.st[0] = nloc; b.st[1] = nx; }
        const unsigned old = xb_add(&bar[XB_XSUB(b.x)], 1u);
        const unsigned gen = old / nloc;
        if (old + 1u == (gen + 1u) * nloc) {
            __builtin_amdgcn_fence(__ATOMIC_RELEASE, "agent");
            asm volatile("s_waitcnt vmcnt(0)" ::: "memory");
            const unsigned og = xb_add(&bar[XB_TOP], 1u);
            const unsigned tg = og / nx;
            if (og + 1u == (tg + 1u) * nx) xb_add(&bar[XB_TOPGEN], 1u);
            else XB_SPIN(xb_ld(&bar[XB_TOPGEN]) == tg, bar);
            __builtin_amdgcn_fence(__ATOMIC_ACQUIRE, "agent");
            xb_add(&bar[XB_XGEN(b.x)], 1u);
            asm volatile("s_waitcnt vmcnt(0)" ::: "memory");
        } else {
            XB_SPIN(xb_ld(&bar[XB_XGEN(b.x)]) == gen, bar);
            __builtin_amdgcn_fence(__ATOMIC_ACQUIRE, "agent");
            asm volatile("s_waitcnt vmcnt(0)" ::: "memory");
        }
    }
    __syncthreads();
}

namespace pg8 {
#define PG8_LAS __attribute__((address_space(3)))
typedef unsigned short bf16_t;
typedef short bf16x8 __attribute__((ext_vector_type(8)));
typedef float f32x4 __attribute__((ext_vector_type(4)));
typedef float f32x2 __attribute__((ext_vector_type(2)));
typedef unsigned u32x4 __attribute__((ext_vector_type(4)));
typedef unsigned u32x2 __attribute__((ext_vector_type(2)));
constexpr int BM = 256, BK = 64, HALF = 128, HTB = HALF * BK * 2  , STAGE_BYTES = 8 * HTB, NXCD = 8, WGM = 8;

__host__ __device__ __forceinline__ int lds_byte(int r, int c) { const int st = (r >> 4) * 2 + (c >> 5), rr = r & 15, cc = c & 31, ob = rr * 64 + cc * 2; return st * 1024 + (ob ^ (((ob >> 9) & 1) << 5)); }
__host__ __device__ __forceinline__ void stage_rc(int b, int& R, int& C) { const int st = b / 1024, sb = b % 1024, swz = sb ^ (((sb >> 9) & 1) << 5); R = (st >> 1) * 16 + swz / 64; C = (st & 1) * 32 + (swz % 64) / 2; }
__host__ __device__ __forceinline__ int perm32(int rho) { const int n = rho >> 4, i = rho & 15; return 8 * (i >> 2) + 4 * n + (i & 3); }

struct Unit { int pm, pn; };
struct Gemm { const bf16_t* A; const bf16_t* Bt; int M, N, K; };

struct StaticOrder {
    int nM, nN, nwg, G, c;
    __host__ __device__ void init(int M, int N, int G_, int c_) { nM = M / BM; nN = N / BM; nwg = nM * nN; G = G_; c = c_; }
    __host__ __device__ bool next(int i, Unit& u) const {
        const long L = (long)i * G + c; if (L >= nwg) return false;
        int wgid = (int)L; { const int q = nwg / NXCD, r = nwg % NXCD, xcd = wgid % NXCD, off = wgid / NXCD; wgid = (xcd < r ? xcd * (q + 1) : r * (q + 1) + (xcd - r) * q) + off; }
        const int nig = WGM * nN, gid = wgid / nig, fm = gid * WGM, gsz = (nM - fm) < WGM ? (nM - fm) : WGM;
        u.pm = fm + ((wgid % nig) % gsz); u.pn = (wgid % nig) / gsz; return true;
    }
    __device__ __forceinline__ void a_ready(const Unit&) const {}
    __device__ __forceinline__ void done(const Unit&) const {}
};

__device__ __forceinline__ unsigned cvt_pk_bf16(float lo, float hi) { unsigned r; asm volatile("v_cvt_pk_bf16_f32 %0, %1, %2" : "=v"(r) : "v"(lo), "v"(hi)); return r; }
__device__ __forceinline__ float bf_lo(unsigned w) { return __uint_as_float(w << 16); }
__device__ __forceinline__ float bf_hi(unsigned w) { return __uint_as_float(w & 0xffff0000u); }

template <class Epi, class Sched, bool ALIGN_EPI = false, bool SP2 = false>
__device__ __forceinline__ void gemm_phase(PG8_LAS unsigned char* lds, const Gemm g, const Sched& S, const Epi& E, const int wid) {
    const int lane = my_lane(), tid = wid * 64 + lane, wr = wid >> 2, wc = wid & 3, fr = lane & 15, fq = lane >> 4;
    const int K = g.K, nt = K / BK;
    unsigned voffA[2], voffB[2];
#pragma unroll
    for (int i = 0; i < 2; ++i) { int R, C; stage_rc(tid * 16 + i * 8192, R, C); const int Rb = Epi::PERM ? ((R & ~31) + perm32(R & 31)) : R;
        voffA[i] = (unsigned)(R * K + C) * 2u; voffB[i] = (unsigned)(Rb * K + C) * 2u; }
    const size_t kstep = (size_t)(BK * 2);
    const size_t hstep = (size_t)HALF * K * 2;
    const size_t tstep = 2 * hstep;
    const unsigned ldsw = (unsigned)wid * 1024u;
    const int aoff = lds_byte(wr * 64 + fr, fq * 8), boff = lds_byte(wc * 32 + fr, fq * 8);
#define PG8_SA(b, h) (((b) * 2 + (h)) * HTB)
#define PG8_SB(b, h) ((4 + (b) * 2 + (h)) * HTB)
#define PG8_STAGE(bufoff, gbase, voff) do { _Pragma("unroll") for (int _i = 0; _i < 2; ++_i) \
        __builtin_amdgcn_global_load_lds((const unsigned*)((const char*)(gbase) + (voff)[_i]), (PG8_LAS unsigned*)(lds + (bufoff) + ldsw + _i * 8192), 16, 0, 0); } while (0)
#define PG8_LDA(dst, b, h) do { _Pragma("unroll") for (int m = 0; m < 4; ++m) _Pragma("unroll") for (int k = 0; k < 2; ++k) dst[m][k] = *(const PG8_LAS bf16x8*)(lds + PG8_SA(b, h) + aoff + m * 2048 + k * 1024); } while (0)
#define PG8_LDB(dst, b, h) do { _Pragma("unroll") for (int n = 0; n < 2; ++n) _Pragma("unroll") for (int k = 0; k < 2; ++k) dst[n][k] = *(const PG8_LAS bf16x8*)(lds + PG8_SB(b, h) + boff + n * 2048 + k * 1024); } while (0)
#define PG8_MMA(ai, bj, At, Bt) do { __builtin_amdgcn_s_setprio(1); _Pragma("unroll") for (int m = 0; m < 4; ++m) _Pragma("unroll") for (int n = 0; n < 2; ++n) _Pragma("unroll") for (int k = 0; k < 2; ++k) \
        acc[ai][bj][m][n] = __builtin_amdgcn_mfma_f32_16x16x32_bf16(Bt[n][k], At[m][k], acc[ai][bj][m][n], 0, 0, 0); __builtin_amdgcn_s_setprio(0); } while (0)
#define PG8_WAIT_V(n) asm volatile("s_waitcnt vmcnt(" #n ")" ::: "memory")
#define PG8_WAIT_L(n) asm volatile("s_waitcnt lgkmcnt(" #n ")" ::: "memory")
#define PG8_BAR __builtin_amdgcn_s_barrier()
#define PG8_SCHED __builtin_amdgcn_sched_barrier(0)
    Unit cur, nxt; int ui = 0;
    if (!S.next(0, cur)) return;
    f32x4 acc[2][2][4][2];
#pragma unroll
    for (int a = 0; a < 2; ++a)
#pragma unroll
        for (int b = 0; b < 2; ++b)
#pragma unroll
            for (int m = 0; m < 4; ++m)
#pragma unroll
                for (int n = 0; n < 2; ++n) acc[a][b][m][n] = (f32x4){0.f, 0.f, 0.f, 0.f};
    bf16x8 At[4][2], B0[2][2], B1[2][2];
    const char* cA = (const char*)g.A + (size_t)cur.pm * tstep; const char* cB = (const char*)g.Bt + (size_t)cur.pn * tstep;
    S.a_ready(cur);
    if constexpr (SP2) {
        PG8_STAGE(PG8_SB(0, 0), cB, voffB); PG8_STAGE(PG8_SB(0, 1), cB + hstep, voffB); PG8_STAGE(PG8_SA(0, 0), cA, voffA); PG8_STAGE(PG8_SA(0, 1), cA + hstep, voffA);
        if (wr == 1) PG8_BAR;
        PG8_WAIT_V(2); PG8_BAR;
        PG8_STAGE(PG8_SB(1, 0), cB + kstep, voffB); PG8_STAGE(PG8_SA(1, 0), cA + kstep, voffA); PG8_STAGE(PG8_SB(1, 1), cB + hstep + kstep, voffB);
        PG8_WAIT_V(6); PG8_BAR;
    } else {
        PG8_STAGE(PG8_SB(0, 0), cB, voffB); PG8_STAGE(PG8_SA(0, 0), cA, voffA); PG8_STAGE(PG8_SB(0, 1), cB + hstep, voffB); PG8_STAGE(PG8_SA(0, 1), cA + hstep, voffA);
        if (wr == 1) PG8_BAR;
        PG8_WAIT_V(4); PG8_BAR;
        PG8_STAGE(PG8_SB(1, 0), cB + kstep, voffB); PG8_STAGE(PG8_SA(1, 0), cA + kstep, voffA); PG8_STAGE(PG8_SB(1, 1), cB + hstep + kstep, voffB);
        PG8_WAIT_V(6); PG8_BAR;
    }
    for (;;) {
        const bool has_next = S.next(ui + 1, nxt);
        const char* nA = has_next ? (const char*)g.A + (size_t)nxt.pm * tstep : cA; const char* nB = has_next ? (const char*)g.Bt + (size_t)nxt.pn * tstep : cB;
        for (int t = 0; t < nt; t += 2) {
            const bool last = (t == nt - 2);
            const char* a1 = cA + (size_t)(t + 1) * kstep;
            const char* a2 = last ? nA : cA + (size_t)(t + 2) * kstep; const char* b2 = last ? nB : cB + (size_t)(t + 2) * kstep;
            const char* a3 = a2 + kstep; const char* b3 = b2 + kstep;
            if (last && has_next) S.a_ready(nxt);
            if constexpr (Epi::HAS_MID) { if (t == (nt >> 1)) E.mid(acc, cur, wr, wc, fr, fq); }
            if constexpr (SP2) {
            PG8_LDB(B0, 0, 0); PG8_LDB(B1, 0, 1); PG8_SCHED; PG8_LDA(At, 0, 0); PG8_STAGE(PG8_SA(1, 1), a1 + hstep, voffA);
            PG8_WAIT_V(8); PG8_WAIT_L(0); PG8_BAR; PG8_MMA(0, 0, At, B0); PG8_MMA(0, 1, At, B1); PG8_BAR; PG8_SCHED;
            PG8_LDA(At, 0, 1); PG8_STAGE(PG8_SB(0, 0), b2, voffB); PG8_STAGE(PG8_SB(0, 1), b2 + hstep, voffB); PG8_STAGE(PG8_SA(0, 0), a2, voffA);
            PG8_WAIT_V(8); PG8_WAIT_L(0); PG8_BAR; PG8_MMA(1, 0, At, B0); PG8_MMA(1, 1, At, B1); PG8_BAR; PG8_SCHED;
            PG8_LDB(B0, 1, 0); PG8_LDB(B1, 1, 1); PG8_SCHED; PG8_LDA(At, 1, 0); PG8_STAGE(PG8_SA(0, 1), a2 + hstep, voffA);
            PG8_WAIT_V(8); PG8_WAIT_L(0); PG8_BAR; PG8_MMA(0, 0, At, B0); PG8_MMA(0, 1, At, B1); PG8_BAR; PG8_SCHED;
            PG8_LDA(At, 1, 1); PG8_STAGE(PG8_SB(1, 0), b3, voffB); PG8_STAGE(PG8_SB(1, 1), b3 + hstep, voffB); PG8_STAGE(PG8_SA(1, 0), a3, voffA);
            PG8_WAIT_V(8); PG8_WAIT_L(0); PG8_BAR; PG8_MMA(1, 0, At, B0); PG8_MMA(1, 1, At, B1); PG8_BAR; PG8_SCHED;
            } else {
            PG8_LDB(B0, 0, 0); PG8_SCHED; PG8_LDA(At, 0, 0); PG8_STAGE(PG8_SA(1, 1), a1 + hstep, voffA);
            PG8_WAIT_L(8); PG8_BAR; PG8_WAIT_L(0); PG8_MMA(0, 0, At, B0); PG8_BAR; PG8_SCHED;
            PG8_LDB(B1, 0, 1); PG8_STAGE(PG8_SB(0, 0), b2, voffB);
            PG8_BAR; PG8_WAIT_L(0); PG8_MMA(0, 1, At, B1); PG8_BAR;
            PG8_LDA(At, 0, 1); PG8_STAGE(PG8_SA(0, 0), a2, voffA);
            PG8_BAR; PG8_WAIT_L(0); PG8_MMA(1, 0, At, B0); PG8_BAR; PG8_SCHED;
            PG8_STAGE(PG8_SB(0, 1), b2 + hstep, voffB);
            PG8_WAIT_V(6); PG8_BAR; PG8_MMA(1, 1, At, B1); PG8_BAR;
            PG8_LDB(B0, 1, 0); PG8_SCHED; PG8_LDA(At, 1, 0); PG8_STAGE(PG8_SA(0, 1), a2 + hstep, voffA);
            PG8_WAIT_L(8); PG8_BAR; PG8_WAIT_L(0); PG8_MMA(0, 0, At, B0); PG8_BAR; PG8_SCHED;
            PG8_LDB(B1, 1, 1); PG8_STAGE(PG8_SB(1, 0), b3, voffB);
            PG8_BAR; PG8_WAIT_L(0); PG8_MMA(0, 1, At, B1); PG8_BAR;
            PG8_LDA(At, 1, 1); PG8_STAGE(PG8_SA(1, 0), a3, voffA);
            PG8_BAR; PG8_WAIT_L(0); PG8_MMA(1, 0, At, B0); PG8_BAR; PG8_SCHED;
            PG8_STAGE(PG8_SB(1, 1), b3 + hstep, voffB);
            PG8_WAIT_V(6); PG8_BAR; PG8_MMA(1, 1, At, B1); PG8_BAR;
            }
        }
        if constexpr (ALIGN_EPI) { if (wr == 0) PG8_BAR; }
        E(acc, cur, wr, wc, fr, fq); S.done(cur);
        if (!has_next) break;
#pragma unroll
        for (int a = 0; a < 2; ++a)
#pragma unroll
            for (int b = 0; b < 2; ++b)
#pragma unroll
                for (int m = 0; m < 4; ++m)
#pragma unroll
                    for (int n = 0; n < 2; ++n) acc[a][b][m][n] = (f32x4){0.f, 0.f, 0.f, 0.f};
        cur = nxt; cA = nA; cB = nB; ++ui;
        if constexpr (ALIGN_EPI) { if (wr == 1) PG8_BAR; }
    }
    PG8_WAIT_V(0);
    if constexpr (!ALIGN_EPI) { if (wr == 0) PG8_BAR; }
    PG8_BAR;
#undef PG8_SA
#undef PG8_SB
#undef PG8_STAGE
#undef PG8_LDA
#undef PG8_LDB
#undef PG8_MMA
#undef PG8_WAIT_V
#undef PG8_WAIT_L
#undef PG8_BAR
#undef PG8_SCHED
}
}
constexpr int D_MODEL = 1024, BATCH = 16, SEQ = 2048, DEC_BATCH = 32, DEC_SEQ = 64, PAST = 2048;
constexpr int NH = 8, HD = 128, DK = 64, D_FF = 2816, IN_W = 7168;
constexpr int MP = BATCH * SEQ;
constexpr int MS = DEC_BATCH * DEC_SEQ;
constexpr int MT = MP + MS;
constexpr float EPS = 1e-6f;
constexpr float LOG2E = 1.4426950408889634f;
constexpr float C2 = 0.125f * LOG2E;
constexpr float LAM_INIT = 0.2f;
constexpr size_t O_YP = 0, O_YS = O_YP + (size_t)MP * 1024, O_KP = O_YS + (size_t)MS * 1024, O_VP = O_KP + (size_t)MP * 1024,
                 O_KS = O_VP + (size_t)MP * 1024, O_VS = O_KS + (size_t)MS * 1024, O_GM = O_VS + (size_t)MS * 1024, O_END = O_GM + (size_t)MS * 1024;

namespace pg8 {
__device__ __forceinline__ float fast_sigmoid(float z) { return __builtin_amdgcn_rcpf(1.0f + __builtin_amdgcn_exp2f(-z * LOG2E)); }
__device__ __forceinline__ float gelu_tanh(float x) { const float u = 1.5957691216057308f * (x + 0.044715f * x * x * x); return x * fast_sigmoid(u); }

struct EpiInProj {
    static constexpr bool PERM = true, HAS_MID = false;
    const float* r1;
    bf16_t* act0;
    float* out;
    float* gvss;
    const float *qg, *kg;
    __device__ __forceinline__ void operator()(const f32x4 (&acc)[2][2][4][2], const Unit& u, int wr, int wc, int fr, int fq) const {
        const int T = u.pn >> 2, sub = u.pn & 3;
        const int cb = sub * 256 + wc * 64 + 8 * fq;
        const int gi = 8 * fq;
        const bool samp = (u.pm >= MP / 256);
        float* kout = out + (samp ? O_KS - (size_t)MP * 1024 : O_KP);
        float* vout = out + (samp ? O_VS - (size_t)MP * 1024 : O_VP);
        bf16_t* dst = act0 + (size_t)T * ((size_t)MT * 1024);
        f32x4 gq[2][2];
#pragma unroll
        for (int bj = 0; bj < 2; ++bj)
#pragma unroll
            for (int n = 0; n < 2; ++n) gq[bj][n] = (f32x4){0.f, 0.f, 0.f, 0.f};
        if (T == 0) {
#pragma unroll
            for (int bj = 0; bj < 2; ++bj)
#pragma unroll
                for (int n = 0; n < 2; ++n) gq[bj][n] = *(const f32x4*)(qg + gi + 32 * bj + 4 * n) * C2;
        } else if (T == 1) {
#pragma unroll
            for (int bj = 0; bj < 2; ++bj)
#pragma unroll
                for (int n = 0; n < 2; ++n) gq[bj][n] = *(const f32x4*)(kg + gi + 32 * bj + 4 * n);
        }
#pragma unroll
        for (int ai = 0; ai < 2; ++ai)
#pragma unroll
            for (int m = 0; m < 4; ++m) {
                const int row = u.pm * BM + ai * HALF + wr * 64 + m * 16 + fr;
                const float rs = r1[row];
                f32x4 v[2][2];
#pragma unroll
                for (int bj = 0; bj < 2; ++bj)
#pragma unroll
                    for (int n = 0; n < 2; ++n) v[bj][n] = acc[ai][bj][m][n] * rs;
                const size_t ro = (size_t)row * 1024 + cb;
                if (T <= 1) {
                    float ss = 0.f;
#pragma unroll
                    for (int bj = 0; bj < 2; ++bj)
#pragma unroll
                        for (int n = 0; n < 2; ++n) { const f32x4 x = v[bj][n]; ss += (x[0] * x[0] + x[1] * x[1]) + (x[2] * x[2] + x[3] * x[3]); }
                    ss += __shfl_xor(ss, 16); ss += __shfl_xor(ss, 32);
                    const float rn = __builtin_amdgcn_rsqf(ss * (1.0f / 64.0f) + EPS);
#pragma unroll
                    for (int bj = 0; bj < 2; ++bj)
#pragma unroll
                        for (int n = 0; n < 2; ++n) v[bj][n] = v[bj][n] * rn * gq[bj][n];
#pragma unroll
                    for (int bj = 0; bj < 2; ++bj) { u32x4 w; w.x = cvt_pk_bf16(v[bj][0][0], v[bj][0][1]); w.y = cvt_pk_bf16(v[bj][0][2], v[bj][0][3]); w.z = cvt_pk_bf16(v[bj][1][0], v[bj][1][1]); w.w = cvt_pk_bf16(v[bj][1][2], v[bj][1][3]);
                        *(u32x4*)(dst + ro + 32 * bj) = w; }
                    if (T == 1) {
#pragma unroll
                        for (int bj = 0; bj < 2; ++bj)
#pragma unroll
                            for (int n = 0; n < 2; ++n) *(f32x4*)(kout + ro + 32 * bj + 4 * n) = v[bj][n];
                    }
                } else if (T == 2) {
#pragma unroll
                    for (int bj = 0; bj < 2; ++bj) { u32x4 w; w.x = cvt_pk_bf16(v[bj][0][0], v[bj][0][1]); w.y = cvt_pk_bf16(v[bj][0][2], v[bj][0][3]); w.z = cvt_pk_bf16(v[bj][1][0], v[bj][1][1]); w.w = cvt_pk_bf16(v[bj][1][2], v[bj][1][3]);
                        *(u32x4*)(dst + ro + 32 * bj) = w;
#pragma unroll
                        for (int n = 0; n < 2; ++n) *(f32x4*)(vout + ro + 32 * bj + 4 * n) = v[bj][n]; }
                } else if (T == 3 || T == 4) {
                    float ss = 0.f;
#pragma unroll
                    for (int bj = 0; bj < 2; ++bj)
#pragma unroll
                        for (int n = 0; n < 2; ++n)
#pragma unroll
                            for (int j = 0; j < 4; ++j) { const float gl = gelu_tanh(v[bj][n][j]); v[bj][n][j] = gl; ss += gl * gl; }
#pragma unroll
                    for (int bj = 0; bj < 2; ++bj) { u32x4 w; w.x = cvt_pk_bf16(v[bj][0][0], v[bj][0][1]); w.y = cvt_pk_bf16(v[bj][0][2], v[bj][0][3]); w.z = cvt_pk_bf16(v[bj][1][0], v[bj][1][1]); w.w = cvt_pk_bf16(v[bj][1][2], v[bj][1][3]);
                        *(u32x4*)(dst + ro + 32 * bj) = w; }
                    if (T == 4) { ss += __shfl_xor(ss, 16); ss += __shfl_xor(ss, 32); if (fq == 0) gvss[(size_t)row * 16 + sub * 4 + wc] = ss; }
                } else {
#pragma unroll
                    for (int bj = 0; bj < 2; ++bj)
#pragma unroll
                        for (int n = 0; n < 2; ++n)
#pragma unroll
                            for (int j = 0; j < 4; ++j) v[bj][n][j] = fast_sigmoid(fminf(fmaxf(v[bj][n][j], -30.f), 30.f));
#pragma unroll
                    for (int bj = 0; bj < 2; ++bj) { u32x4 w; w.x = cvt_pk_bf16(v[bj][0][0], v[bj][0][1]); w.y = cvt_pk_bf16(v[bj][0][2], v[bj][0][3]); w.z = cvt_pk_bf16(v[bj][1][0], v[bj][1][1]); w.w = cvt_pk_bf16(v[bj][1][2], v[bj][1][3]);
                        *(u32x4*)(dst + ro + 32 * bj) = w; }
                }
            }
    }
};

struct EpiMerge {
    static constexpr bool PERM = true, HAS_MID = true;
    const bf16_t *sga, *sgg; bf16_t* y1;
    __device__ __forceinline__ void mid(f32x4 (&acc)[2][2][4][2], const Unit& u, int wr, int wc, int fr, int fq) const {
        int oz; asm volatile("v_mov_b32 %0, 0" : "=v"(oz));
#pragma unroll
        for (int ai = 0; ai < 2; ++ai)
#pragma unroll
            for (int m = 0; m < 4; ++m) {
                const size_t ro = (size_t)(u.pm * BM + ai * HALF + wr * 64 + m * 16 + fr + oz) * 1024 + u.pn * BM + wc * 32 + 8 * fq;
#pragma unroll
                for (int bj = 0; bj < 2; ++bj) {
                    const u32x4 a = *(const u32x4*)(sga + ro + bj * HALF), g = *(const u32x4*)(sgg + ro + bj * HALF);
                    f32x4 r0, r1;
                    r0[0] = bf_lo(a.x) * __builtin_amdgcn_rcpf(bf_lo(g.x)); r0[1] = bf_hi(a.x) * __builtin_amdgcn_rcpf(bf_hi(g.x));
                    r0[2] = bf_lo(a.y) * __builtin_amdgcn_rcpf(bf_lo(g.y)); r0[3] = bf_hi(a.y) * __builtin_amdgcn_rcpf(bf_hi(g.y));
                    r1[0] = bf_lo(a.z) * __builtin_amdgcn_rcpf(bf_lo(g.z)); r1[1] = bf_hi(a.z) * __builtin_amdgcn_rcpf(bf_hi(g.z));
                    r1[2] = bf_lo(a.w) * __builtin_amdgcn_rcpf(bf_lo(g.w)); r1[3] = bf_hi(a.w) * __builtin_amdgcn_rcpf(bf_hi(g.w));
                    acc[ai][bj][m][0] = acc[ai][bj][m][0] * r0; acc[ai][bj][m][1] = acc[ai][bj][m][1] * r1;
                }
                asm volatile("" ::: "memory");
            }
    }
    __device__ __forceinline__ void operator()(const f32x4 (&acc)[2][2][4][2], const Unit& u, int wr, int wc, int fr, int fq) const {
#pragma unroll
        for (int ai = 0; ai < 2; ++ai)
#pragma unroll
            for (int m = 0; m < 4; ++m) {
                const size_t ro = (size_t)(u.pm * BM + ai * HALF + wr * 64 + m * 16 + fr) * 1024 + u.pn * BM + wc * 32 + 8 * fq;
#pragma unroll
                for (int bj = 0; bj < 2; ++bj) {
                    const u32x4 g = *(const u32x4*)(sgg + ro + bj * HALF);
                    const f32x4 v0 = acc[ai][bj][m][0], v1 = acc[ai][bj][m][1];
                    u32x4 w;
                    w.x = cvt_pk_bf16(v0[0] * bf_lo(g.x), v0[1] * bf_hi(g.x)); w.y = cvt_pk_bf16(v0[2] * bf_lo(g.y), v0[3] * bf_hi(g.y));
                    w.z = cvt_pk_bf16(v1[0] * bf_lo(g.z), v1[1] * bf_hi(g.z)); w.w = cvt_pk_bf16(v1[2] * bf_lo(g.w), v1[3] * bf_hi(g.w));
                    *(u32x4*)(y1 + ro + bj * HALF) = w;
                }
                asm volatile("" ::: "memory");
            }
    }
};

struct EpiOutRes {
    static constexpr bool PERM = false, HAS_MID = false;
    const float *xp, *xs; float* x1f; bf16_t* x1b; float* x1ss;
    __device__ __forceinline__ void operator()(const f32x4 (&acc)[2][2][4][2], const Unit& u, int wr, int wc, int fr, int fq) const {
        const float* xb = (u.pm >= MP / 256) ? xs - (size_t)MP * 1024 : xp;
        const int col0 = u.pn * BM + wc * 32 + 4 * fq;
#pragma unroll
        for (int ai = 0; ai < 2; ++ai)
#pragma unroll
            for (int m = 0; m < 4; ++m) {
                const int row = u.pm * BM + ai * HALF + wr * 64 + m * 16 + fr; const size_t ro = (size_t)row * 1024 + col0;
                float ss = 0.f;
#pragma unroll
                for (int bj = 0; bj < 2; ++bj)
#pragma unroll
                    for (int n = 0; n < 2; ++n) { const f32x4 x = *(const f32x4*)(xb + ro + bj * HALF + n * 16) + acc[ai][bj][m][n];
                        *(f32x4*)(x1f + ro + bj * HALF + n * 16) = x; ss += (x[0] * x[0] + x[1] * x[1]) + (x[2] * x[2] + x[3] * x[3]);
                        u32x2 w; w.x = cvt_pk_bf16(x[0], x[1]); w.y = cvt_pk_bf16(x[2], x[3]); *(u32x2*)(x1b + ro + bj * HALF + n * 16) = w; }
                ss += __shfl_xor(ss, 16); ss += __shfl_xor(ss, 32);
                if (fq == 0) x1ss[(size_t)row * 16 + u.pn * 4 + wc] = ss;
            }
    }
};

struct EpiSwiGLU {
    static constexpr bool PERM = true, HAS_MID = false;
    const float* x1ss; bf16_t* act;
    __device__ __forceinline__ void operator()(const f32x4 (&acc)[2][2][4][2], const Unit& u, int wr, int wc, int fr, int fq) const {
        const int col0 = u.pn * 128 + wc * 32 + 8 * fq;
#pragma unroll
        for (int ai = 0; ai < 2; ++ai)
#pragma unroll
            for (int m = 0; m < 4; ++m) {
                const int row = u.pm * BM + ai * HALF + wr * 64 + m * 16 + fr;
                const f32x4* sp = (const f32x4*)(x1ss + (size_t)row * 16);
                const f32x4 s0 = sp[0], s1 = sp[1], s2 = sp[2], s3 = sp[3];
                const float tot = ((s0[0] + s0[1]) + (s0[2] + s0[3])) + ((s1[0] + s1[1]) + (s1[2] + s1[3])) + ((s2[0] + s2[1]) + (s2[2] + s2[3])) + ((s3[0] + s3[1]) + (s3[2] + s3[3]));
                const float rs = __builtin_amdgcn_rsqf(tot * (1.0f / 1024.0f) + EPS);
                u32x4 w; float o[8];
#pragma unroll
                for (int n = 0; n < 2; ++n)
#pragma unroll
                    for (int j = 0; j < 4; ++j) { const float gg = acc[ai][0][m][n][j] * rs, uu = acc[ai][1][m][n][j] * rs; o[4 * n + j] = gg * fast_sigmoid(gg) * uu; }
                w.x = cvt_pk_bf16(o[0], o[1]); w.y = cvt_pk_bf16(o[2], o[3]); w.z = cvt_pk_bf16(o[4], o[5]); w.w = cvt_pk_bf16(o[6], o[7]);
                *(u32x4*)(act + (size_t)row * D_FF + col0) = w;
            }
    }
};

struct EpiFinal {
    static constexpr bool PERM = false, HAS_MID = false;
    const float* x1f; float* out;
    __device__ __forceinline__ void operator()(const f32x4 (&acc)[2][2][4][2], const Unit& u, int wr, int wc, int fr, int fq) const {
        float* ob = out + ((u.pm >= MP / 256) ? O_YS - (size_t)MP * 1024 : O_YP);
        const int col0 = u.pn * BM + wc * 32 + 4 * fq;
#pragma unroll
        for (int ai = 0; ai < 2; ++ai)
#pragma unroll
            for (int m = 0; m < 4; ++m) {
                const size_t ro = (size_t)(u.pm * BM + ai * HALF + wr * 64 + m * 16 + fr) * 1024 + col0;
#pragma unroll
                for (int bj = 0; bj < 2; ++bj)
#pragma unroll
                    for (int n = 0; n < 2; ++n) *(f32x4*)(ob + ro + bj * HALF + n * 16) = *(const f32x4*)(x1f + ro + bj * HALF + n * 16) + acc[ai][bj][m][n];
            }
    }
};
}
namespace att {
using bf16_t = unsigned short;
using bf16x8 = __attribute__((ext_vector_type(8))) short;
using s16x4  = __attribute__((ext_vector_type(4))) short;
using f32x16 = __attribute__((ext_vector_type(16))) float;
using f32x8  = __attribute__((ext_vector_type(8))) float;
using f32x4  = __attribute__((ext_vector_type(4))) float;
using u32x4  = __attribute__((ext_vector_type(4))) unsigned;
constexpr int KVBLK = 64;
constexpr int SHM_V = 16384, SHM_K = 16384;
constexpr int L_V = 0, L_K = 2 * SHM_V, L_WS = 69632, L_BT = 71680, L_END = 72704;
constexpr int XS = 132;
constexpr float THR = 8.f;
constexpr float NEGBIG = -1e30f;
#define KSWZ(row, colB) ((row) * 256 + ((colB) ^ (((row) & 7) << 4)))
#define SBAR() __builtin_amdgcn_sched_barrier(0)
__device__ __forceinline__ int crow(int r, int hi) { return (r & 3) + 8 * (r >> 2) + 4 * hi; }
__device__ __forceinline__ unsigned cvtpk(float lo, float hi) { unsigned r; asm volatile("v_cvt_pk_bf16_f32 %0, %1, %2" : "=v"(r) : "v"(lo), "v"(hi)); return r; }
template <typename TIn> struct Stage;
template <> struct Stage<bf16_t> { using T = bf16x8;
  __device__ static __forceinline__ T ld8(const bf16_t* p) { return *reinterpret_cast<const bf16x8*>(p); }
  __device__ static __forceinline__ bf16x8 tobf(T x) { return x; } };
template <> struct Stage<float> { using T = f32x8;
  __device__ static __forceinline__ T ld8(const float* p) { return *reinterpret_cast<const f32x8*>(p); }
  __device__ static __forceinline__ bf16x8 tobf(T x) {
    u32x4 w = {cvtpk(x[0], x[1]), cvtpk(x[2], x[3]), cvtpk(x[4], x[5]), cvtpk(x[6], x[7])}; return *reinterpret_cast<bf16x8*>(&w); } };

__device__ __forceinline__ void partialSM(f32x16& p0, f32x16& p1, float& m_reg, float& mn, float& alpha) {
  float pmax = p0[0];
#pragma unroll
  for (int r = 1; r < 16; ++r) pmax = fmaxf(pmax, p0[r]);
#pragma unroll
  for (int r = 0; r < 16; ++r) pmax = fmaxf(pmax, p1[r]);
  { auto rr = __builtin_amdgcn_permlane32_swap(__float_as_uint(pmax), __float_as_uint(pmax), false, false);
    pmax = fmaxf(__uint_as_float(rr[0]), __uint_as_float(rr[1])); }
  if (__builtin_expect(__all(pmax - m_reg <= THR), 1)) { mn = m_reg; alpha = 1.f; }
  else { mn = fmaxf(m_reg, pmax); alpha = __builtin_amdgcn_exp2f(m_reg - mn); m_reg = mn; }
#pragma unroll
  for (int r = 0; r < 16; ++r) p0[r] = p0[r] - mn;
#pragma unroll
  for (int r = 0; r < 16; ++r) p1[r] = p1[r] - mn;
#pragma unroll
  for (int r = 0; r < 16; ++r) p0[r] = __builtin_amdgcn_exp2f(p0[r]);
}
__device__ __forceinline__ void finishSM(f32x16& p0, f32x16& p1, float alpha, float& l_reg, bf16x8& pa0, bf16x8& pa1, bf16x8& pa2, bf16x8& pa3) {
#pragma unroll
  for (int r = 0; r < 16; ++r) p1[r] = __builtin_amdgcn_exp2f(p1[r]);
  float ps = 0;
#pragma unroll
  for (int r = 0; r < 16; ++r) ps += p0[r];
#pragma unroll
  for (int r = 0; r < 16; ++r) ps += p1[r];
  { auto rr = __builtin_amdgcn_permlane32_swap(__float_as_uint(ps), __float_as_uint(ps), false, false);
    ps = __uint_as_float(rr[0]) + __uint_as_float(rr[1]); }
  l_reg = l_reg * alpha + ps;
#define PK4(P, BASE, OUT) do { unsigned a0 = cvtpk(P[BASE + 0], P[BASE + 1]), a1 = cvtpk(P[BASE + 2], P[BASE + 3]);   \
    unsigned b0 = cvtpk(P[BASE + 4], P[BASE + 5]), b1 = cvtpk(P[BASE + 6], P[BASE + 7]);                              \
    auto r0 = __builtin_amdgcn_permlane32_swap(a0, b0, false, false); auto r1 = __builtin_amdgcn_permlane32_swap(a1, b1, false, false); \
    u32x4 w = {r0[0], r1[0], r0[1], r1[1]}; OUT = *reinterpret_cast<bf16x8*>(&w); } while (0)
  PK4(p0, 0, pa0); PK4(p0, 8, pa1); PK4(p1, 0, pa2); PK4(p1, 8, pa3);
#undef PK4
}
__device__ __forceinline__ void qkt(f32x16& p0, f32x16& p1, const char* Ks, const bf16x8* qr, int r32, int hi, int mp, float cinit) {
#pragma unroll
  for (int r = 0; r < 16; ++r) { p0[r] = cinit; p1[r] = cinit; }
#pragma unroll
  for (int d0 = 0; d0 < 4; ++d0) { const int cb = (mp * 64 + d0 * 16 + hi * 8) * 2;
    bf16x8 b0 = *reinterpret_cast<const bf16x8*>(Ks + KSWZ(r32, cb));
    bf16x8 b1 = *reinterpret_cast<const bf16x8*>(Ks + KSWZ(32 + r32, cb));
    p0 = __builtin_amdgcn_mfma_f32_32x32x16_bf16(b0, qr[d0], p0, 0, 0, 0);
    p1 = __builtin_amdgcn_mfma_f32_32x32x16_bf16(b1, qr[d0], p1, 0, 0, 0); }
}
__device__ __forceinline__ int v_st(int k, int c) { const int kk = (k & ~0xC) | ((k & 4) << 1) | ((k & 8) >> 1); return ((kk >> 3) * 4 + (c >> 5)) * 512 + ((kk & 7) * 32 + (c & 31)) * 2; }
__device__ __forceinline__ int v_rd_base(int lane) { return ((lane & 3) << 3) | (((lane >> 2) & 3) << 6) | (((lane >> 4) & 1) << 5) | (((lane >> 5) & 1) << 8); }
constexpr int v_rd_off(int d0, int ks, int half) { return d0 * 512 + ks * 4096 + half * 2048; }
template <int OFF> __device__ __forceinline__ s16x4 tr_read(int vb) {
  s16x4 r; asm volatile("ds_read_b64_tr_b16 %0, %1 offset:%2" : "=&v"(r) : "v"(vb), "i"(OFF) : "memory"); return r;
}
template <int D0> __device__ __forceinline__ void pv_one(f32x16& od, int vb, bf16x8 pa0, bf16x8 pa1, bf16x8 pa2, bf16x8 pa3) {
  const s16x4 l0 = tr_read<v_rd_off(D0, 0, 0)>(vb), h0 = tr_read<v_rd_off(D0, 0, 1)>(vb), l1 = tr_read<v_rd_off(D0, 1, 0)>(vb), h1 = tr_read<v_rd_off(D0, 1, 1)>(vb);
  const s16x4 l2 = tr_read<v_rd_off(D0, 2, 0)>(vb), h2 = tr_read<v_rd_off(D0, 2, 1)>(vb), l3 = tr_read<v_rd_off(D0, 3, 0)>(vb), h3 = tr_read<v_rd_off(D0, 3, 1)>(vb);
  asm volatile("s_waitcnt lgkmcnt(0)" ::: "memory"); SBAR();
#define PK(L, H) (bf16x8){L[0], L[1], L[2], L[3], H[0], H[1], H[2], H[3]}
  od = __builtin_amdgcn_mfma_f32_32x32x16_bf16(pa0, PK(l0, h0), od, 0, 0, 0);
  od = __builtin_amdgcn_mfma_f32_32x32x16_bf16(pa1, PK(l1, h1), od, 0, 0, 0);
  od = __builtin_amdgcn_mfma_f32_32x32x16_bf16(pa2, PK(l2, h2), od, 0, 0, 0);
  od = __builtin_amdgcn_mfma_f32_32x32x16_bf16(pa3, PK(l3, h3), od, 0, 0, 0);
#undef PK
}
__device__ __forceinline__ void pv_d0(f32x16* o, int vb, bf16x8 pa0, bf16x8 pa1, bf16x8 pa2, bf16x8 pa3) {
  pv_one<0>(o[0], vb, pa0, pa1, pa2, pa3); pv_one<1>(o[1], vb, pa0, pa1, pa2, pa3); pv_one<2>(o[2], vb, pa0, pa1, pa2, pa3); pv_one<3>(o[3], vb, pa0, pa1, pa2, pa3);
}

struct AttnArgs {
  const bf16_t *qb, *kb, *vb;
  const float *cache_k, *cache_v;
  const float *newk, *newv;
  bf16_t* ag;
  const float* bias_tab;
  const float* lamp;
  const float* subln_g;
};

template <bool SAMPLE>
__device__ __forceinline__ void attn_unit(const AttnArgs& A, int b, int h, int qt, char* lds, const int wid) {
  using TK = typename std::conditional<SAMPLE, float, bf16_t>::type;
  using St = Stage<TK>;
  const int lane = my_lane(), tid = wid * 64 + lane, r32 = lane & 31, hi = lane >> 5;
  const int rg = wid >> 1, mp = wid & 1, rge = SAMPLE ? (rg & 1) : rg;
  const int NT = SAMPLE ? 34 : 2 * qt + 2;
  const int qpos0 = (SAMPLE ? PAST : qt * 128) + 32 * rge;
  const int rowq = (SAMPLE ? MP + b * DEC_SEQ : b * SEQ + qt * 128) + 32 * rge;
  const int vis_last = SAMPLE ? 32 : 2 * qt + (rg >> 1);
  bf16_t* V_lds = (bf16_t*)(lds + L_V); bf16_t* K_lds = (bf16_t*)(lds + L_K);
  float* ws = (float*)(lds + L_WS) + wid * 64; float* li_l = ws; float* al_l = ws + 32;
  float* bt = (float*)(lds + L_BT);
  if (tid < 192) bt[tid] = A.bias_tab[h * 192 + tid];
  float m_reg = NEGBIG, l_reg = 0; f32x16 o[4];
#pragma unroll
  for (int d = 0; d < 4; ++d)
#pragma unroll
    for (int r = 0; r < 16; ++r) o[d][r] = 0.f;
  bf16x8 qr[4];
  { const bf16_t* Qw = A.qb + (size_t)(rowq + r32) * 1024 + h * 128 + mp * 64 + hi * 8;
#pragma unroll
    for (int d0 = 0; d0 < 4; ++d0) qr[d0] = *reinterpret_cast<const bf16x8*>(Qw + d0 * 16); }
  const int sr = tid >> 4, sc = (tid & 15) * 8, vst0 = v_st(sr, sc), vst1 = v_st(32 + sr, sc);
  const int vb0 = (int)(uintptr_t)V_lds + v_rd_base(lane);
  const TK *kbase, *vbase;
  if constexpr (SAMPLE) { kbase = A.cache_k + (size_t)b * PAST * 1024 + h * 128; vbase = A.cache_v + (size_t)b * PAST * 1024 + h * 128; }
  else { kbase = (const TK*)A.kb + (size_t)b * SEQ * 1024 + h * 128; vbase = (const TK*)A.vb + (size_t)b * SEQ * 1024 + h * 128; }
  const float* nk = A.newk + (size_t)b * DEC_SEQ * 1024 + h * 128; const float* nv = A.newv + (size_t)b * DEC_SEQ * 1024 + h * 128;
  struct { typename St::T vs0, vs1, ks0, ks1; } sg;
#define KSRC(t) (SAMPLE ? (((t) < 32) ? (const TK*)(kbase + (size_t)(t) * KVBLK * 1024) : (const TK*)nk) : (const TK*)(kbase + (size_t)(t) * KVBLK * 1024))
#define VSRC(t) (SAMPLE ? (((t) < 32) ? (const TK*)(vbase + (size_t)(t) * KVBLK * 1024) : (const TK*)nv) : (const TK*)(vbase + (size_t)(t) * KVBLK * 1024))
#define SLOAD(t) do { const TK* kp_ = KSRC(t); const TK* vp_ = VSRC(t); \
    sg.vs0 = St::ld8(vp_ + (size_t)sr * 1024 + sc); sg.vs1 = St::ld8(vp_ + (size_t)(32 + sr) * 1024 + sc); \
    sg.ks0 = St::ld8(kp_ + (size_t)sr * 1024 + sc); sg.ks1 = St::ld8(kp_ + (size_t)(32 + sr) * 1024 + sc); } while (0)
#define SWRITE(bf) do { *(bf16x8*)((char*)V_lds + (bf) * SHM_V + vst0) = St::tobf(sg.vs0);          \
    *(bf16x8*)((char*)V_lds + (bf) * SHM_V + vst1) = St::tobf(sg.vs1); const int kc = sc * 2;               \
    *(bf16x8*)((char*)K_lds + (bf) * SHM_K + KSWZ(sr, kc)) = St::tobf(sg.ks0);                       \
    *(bf16x8*)((char*)K_lds + (bf) * SHM_K + KSWZ(32 + sr, kc)) = St::tobf(sg.ks1); } while (0)
#define RESC(a) do { if (__any((a) < 1.f)) { if (hi == 0) al_l[r32] = (a); asm volatile("s_waitcnt lgkmcnt(0)" ::: "memory"); \
    _Pragma("unroll") for (int d = 0; d < 4; ++d) _Pragma("unroll") for (int r = 0; r < 16; ++r) o[d][r] *= al_l[crow(r, hi)]; } } while (0)
#define T_MASKED(t) ((t) > vis_last)
#define T_FAR(t) (64 * (t) + 63 - qpos0 <= -91)
#define CINIT(t) ((!T_MASKED(t) && T_FAR(t)) ? bt0 : 0.f)
#define FIX(P0, P1, t) do { if (T_MASKED(t)) { _Pragma("unroll") for (int r = 0; r < 16; ++r) { P0[r] = NEGBIG; P1[r] = NEGBIG; } } \
    else if (!T_FAR(t)) { const int db_ = 64 * (t) - (qpos0 + r32) + 127; \
      _Pragma("unroll") for (int r = 0; r < 16; ++r) { const int i0_ = db_ + crow(r, hi); P0[r] += bt[i0_ < 0 ? 0 : i0_]; const int i1_ = i0_ + 32; P1[r] += bt[i1_ < 0 ? 0 : i1_]; } } } while (0)
  f32x16 pA0, pA1, pB0, pB1; float mnA = 0.f, mnB = 0.f, alA = 1.f, alB = 1.f; bf16x8 pa0, pa1, pa2, pa3;
  const bool act = !SAMPLE || rg < 2;
  SLOAD(0); asm volatile("s_waitcnt vmcnt(0)" ::: "memory"); SWRITE(0); __syncthreads();
  const float bt0 = bt[0];
  if (act) { qkt(pA0, pA1, (const char*)K_lds, qr, r32, hi, mp, CINIT(0)); FIX(pA0, pA1, 0); partialSM(pA0, pA1, m_reg, mnA, alA); }
  SLOAD(1); asm volatile("s_waitcnt vmcnt(0)" ::: "memory"); SWRITE(1); __syncthreads();
  for (int j = 1; j + 1 < NT; j += 2) {
    SBAR(); if (act) { qkt(pB0, pB1, (const char*)K_lds + SHM_K, qr, r32, hi, mp, CINIT(j)); FIX(pB0, pB1, j);
    finishSM(pA0, pA1, alA, l_reg, pa0, pa1, pa2, pa3); } SBAR();
    SLOAD(j + 1); SBAR();
    if (act) { pv_d0(o, vb0, pa0, pa1, pa2, pa3); partialSM(pB0, pB1, m_reg, mnB, alB); }
    __syncthreads(); asm volatile("s_waitcnt vmcnt(0)" ::: "memory"); SWRITE(0);
    if (act) RESC(alB); __syncthreads();
    SBAR(); if (act) { qkt(pA0, pA1, (const char*)K_lds, qr, r32, hi, mp, CINIT(j + 1)); FIX(pA0, pA1, j + 1);
    finishSM(pB0, pB1, alB, l_reg, pa0, pa1, pa2, pa3); } SBAR();
    { const int tn = (j + 2 < NT) ? j + 2 : NT - 1; SLOAD(tn); } SBAR();
    if (act) { pv_d0(o, vb0 + SHM_V, pa0, pa1, pa2, pa3); partialSM(pA0, pA1, m_reg, mnA, alA); }
    __syncthreads(); asm volatile("s_waitcnt vmcnt(0)" ::: "memory"); SWRITE(1);
    if (act) RESC(alA); __syncthreads();
  }
  SBAR(); if (act) { qkt(pB0, pB1, (const char*)K_lds + SHM_K, qr, r32, hi, mp, CINIT(NT - 1)); FIX(pB0, pB1, NT - 1);
  finishSM(pA0, pA1, alA, l_reg, pa0, pa1, pa2, pa3); SBAR();
  pv_d0(o, vb0, pa0, pa1, pa2, pa3); partialSM(pB0, pB1, m_reg, mnB, alB); }
  __syncthreads();
  if (act) { RESC(alB);
  finishSM(pB0, pB1, alB, l_reg, pa0, pa1, pa2, pa3); SBAR();
  pv_d0(o, vb0 + SHM_V, pa0, pa1, pa2, pa3); }
  if (hi == 0) li_l[r32] = l_reg; asm volatile("s_waitcnt lgkmcnt(0)" ::: "memory");
  const float lamv = mp ? A.lamp[0] : 1.f;
  float sc16[16];
#pragma unroll
  for (int r = 0; r < 16; ++r) sc16[r] = __builtin_amdgcn_rcpf(li_l[crow(r, hi)]) * lamv;
  __syncthreads();
  float* X = (float*)lds + rg * (32 * XS);
  if (mp == 1) {
#pragma unroll
    for (int r = 0; r < 16; ++r)
#pragma unroll
      for (int d0 = 0; d0 < 4; ++d0) X[crow(r, hi) * XS + d0 * 32 + r32] = o[d0][r] * sc16[r];
  }
  __syncthreads();
  if (mp == 0) {
#pragma unroll
    for (int r = 0; r < 16; ++r)
#pragma unroll
      for (int d0 = 0; d0 < 4; ++d0) { const int ix = crow(r, hi) * XS + d0 * 32 + r32; X[ix] = o[d0][r] * sc16[r] - X[ix]; }
    asm volatile("s_waitcnt lgkmcnt(0)" ::: "memory");
    const int row = lane >> 1, half = lane & 1;
    const f32x4* xr = (const f32x4*)(X + row * XS + 64 * half);
    f32x4 xv[16]; float ss = 0.f;
#pragma unroll
    for (int i = 0; i < 16; ++i) { xv[i] = xr[i]; ss += (xv[i][0] * xv[i][0] + xv[i][1] * xv[i][1]) + (xv[i][2] * xv[i][2] + xv[i][3] * xv[i][3]); }
    ss += __shfl_xor(ss, 1);
    const float rn = __builtin_amdgcn_rsqf(ss * (1.0f / 128.0f) + EPS) * (1.0f - LAM_INIT);
    if (!SAMPLE || rg < 2) {
      bf16_t* op = A.ag + (size_t)(rowq + row) * 2048 + h * 128 + 64 * half;
      const f32x4* gp = (const f32x4*)(A.subln_g + 64 * half);
#pragma unroll
      for (int i = 0; i < 8; ++i) { const f32x4 g0 = gp[2 * i], g1 = gp[2 * i + 1]; const f32x4 a0 = xv[2 * i] * g0 * rn, a1 = xv[2 * i + 1] * g1 * rn;
        u32x4 w = {cvtpk(a0[0], a0[1]), cvtpk(a0[2], a0[3]), cvtpk(a1[0], a1[1]), cvtpk(a1[2], a1[3])}; *(u32x4*)(op + 8 * i) = w; }
    }
  }
  __syncthreads();
#undef KSRC
#undef VSRC
#undef SLOAD
#undef SWRITE
#undef RESC
#undef T_MASKED
#undef T_FAR
#undef CINIT
#undef FIX
}

struct SguArgs {
  const bf16_t *gub, *gvb;
  const float* gvss;
  const bf16_t* wm;
  const float *gn, *gmb;
  bf16_t* ag;
  float* out;
};
constexpr int SG_WM = 0, SG_GT = 34816, SG_RS = 69632, SG_STR = 136;
__device__ __forceinline__ void sgu_item(const SguArgs& S, int row0, int g, bool samp, char* lds, const int wid) {
  const int lane = my_lane(), tid = wid * 64 + lane, r32 = lane & 31, hi = lane >> 5;
  const int T = samp ? 64 : 128;
  bf16_t* wmL = (bf16_t*)(lds + SG_WM); bf16_t* gvT = (bf16_t*)(lds + SG_GT); float* rsL = (float*)(lds + SG_RS);
  if (tid < 128) { float r = 0.f;
    if (tid < T) { const f32x4* sp = (const f32x4*)(S.gvss + (size_t)(row0 + tid) * 16); const f32x4 s0 = sp[0], s1 = sp[1], s2 = sp[2], s3 = sp[3];
      const float tot = ((s0[0] + s0[1]) + (s0[2] + s0[3])) + ((s1[0] + s1[1]) + (s1[2] + s1[3])) + ((s2[0] + s2[1]) + (s2[2] + s2[3])) + ((s3[0] + s3[1]) + (s3[2] + s3[3]));
      r = __builtin_amdgcn_rsqf(tot * (1.0f / 1024.0f) + EPS); }
    rsL[tid] = r; }
#pragma unroll
  for (int i = 0; i < 4; ++i) { const int ch = tid + 512 * i, rw = ch >> 4, c8 = (ch & 15) * 8;
    *(u32x4*)(wmL + rw * SG_STR + c8) = *(const u32x4*)(S.wm + (size_t)g * 16384 + rw * 128 + c8); }
  __syncthreads();
#pragma unroll 1
  for (int i = 0; i < 4; ++i) { const int ch = tid + 512 * i, s = ch >> 4, cc = (ch & 15) * 8;
    u32x4 x = {0u, 0u, 0u, 0u};
    if (s < T) x = *(const u32x4*)(S.gvb + (size_t)(row0 + s) * 1024 + g * 128 + cc);
    const float r = rsL[s];
    float f[8] = {__uint_as_float(x.x << 16) * r, __uint_as_float(x.x & 0xffff0000u) * r, __uint_as_float(x.y << 16) * r, __uint_as_float(x.y & 0xffff0000u) * r,
                  __uint_as_float(x.z << 16) * r, __uint_as_float(x.z & 0xffff0000u) * r, __uint_as_float(x.w << 16) * r, __uint_as_float(x.w & 0xffff0000u) * r};
#pragma unroll
    for (int j = 0; j < 8; j += 2) { const unsigned w = cvtpk(f[j], f[j + 1]); gvT[(cc + j) * SG_STR + s] = (bf16_t)(w & 0xffffu); gvT[(cc + j + 1) * SG_STR + s] = (bf16_t)(w >> 16); }
    if (samp && s < T) { const f32x4* gp = (const f32x4*)(S.gn + g * 128 + cc); const f32x4 g0 = gp[0], g1 = gp[1];
      float* op = S.out + O_GM + (size_t)(row0 - MP + s) * 1024 + g * 128 + cc;
      *(f32x4*)op = (f32x4){f[0] * g0[0], f[1] * g0[1], f[2] * g0[2], f[3] * g0[3]}; *(f32x4*)(op + 4) = (f32x4){f[4] * g1[0], f[5] * g1[1], f[6] * g1[2], f[7] * g1[3]}; }
  }
  __syncthreads();
  const int tb = wid >> 1, cbp = wid & 1;
  if (32 * tb < T) {
    f32x16 acc[2];
#pragma unroll
    for (int c = 0; c < 2; ++c)
#pragma unroll
      for (int r = 0; r < 16; ++r) acc[c][r] = 0.f;
    for (int ks = 0; ks <= 2 * tb + 1; ++ks) {
      const bf16x8 a = *(const bf16x8*)(wmL + (32 * tb + r32) * SG_STR + 16 * ks + 8 * hi);
#pragma unroll
      for (int c = 0; c < 2; ++c) { const bf16x8 bfr = *(const bf16x8*)(gvT + (32 * (2 * cbp + c) + r32) * SG_STR + 16 * ks + 8 * hi);
        acc[c] = __builtin_amdgcn_mfma_f32_32x32x16_bf16(a, bfr, acc[c], 0, 0, 0); }
    }
#pragma unroll
    for (int c = 0; c < 2; ++c) { const int col = g * 128 + 32 * (2 * cbp + c) + r32; const float gnc = S.gn[col];
#pragma unroll
      for (int r = 0; r < 16; ++r) { const int t = 32 * tb + crow(r, hi); const size_t grow = (size_t)(row0 + t);
        const float z = acc[c][r] * gnc + S.gmb[g * 128 + t];
        const float gu = __uint_as_float((unsigned)S.gub[grow * 1024 + col] << 16);
        const unsigned w = cvtpk(gu * z, 0.f); S.ag[grow * 2048 + 1024 + col] = (bf16_t)(w & 0xffffu); } }
  }
  __syncthreads();
}
#undef KSWZ
#undef SBAR
}
typedef unsigned short bf16;
typedef unsigned v4u __attribute__((ext_vector_type(4)));
typedef float f32x4 __attribute__((ext_vector_type(4)));
constexpr int NWAVES = 8;
constexpr int LDS_BYTES = 131072 + 64;
constexpr int LDS_MISC = 131072;
constexpr size_t WS_CTL = 0, CTL_BYTES = 16384;
constexpr size_t MiB = 1u << 20;
constexpr size_t SZ_ACT = (size_t)MT * 1024 * 2;
constexpr size_t WS_BT1 = CTL_BYTES;
constexpr size_t WS_BT3 = WS_BT1 + (size_t)IN_W * 1024 * 2;
constexpr size_t WS_BT4 = WS_BT3 + (size_t)1024 * 2048 * 2;
constexpr size_t WS_BT5 = WS_BT4 + (size_t)1024 * 1024 * 2;
constexpr size_t WS_BT6 = WS_BT5 + (size_t)2 * D_FF * 1024 * 2;
constexpr size_t WS_WM  = WS_BT6 + (size_t)1024 * D_FF * 2;
constexpr size_t WS_MISC = WS_WM + (size_t)8 * 128 * 128 * 2;
constexpr size_t WS_R1  = WS_MISC + 8192;
constexpr size_t WS_GVSS = WS_R1 + (size_t)MT * 4;
constexpr size_t WS_X1SS = WS_GVSS + (size_t)MT * 64;
constexpr size_t WS_XB  = ((WS_X1SS + (size_t)MT * 64 + 4095) / 4096) * 4096;
constexpr size_t WS_Q   = WS_XB + SZ_ACT;
constexpr size_t WS_K   = WS_Q + SZ_ACT, WS_V = WS_K + SZ_ACT, WS_GU = WS_V + SZ_ACT, WS_GV = WS_GU + SZ_ACT;
constexpr size_t WS_SGA = WS_GV + SZ_ACT, WS_SGG = WS_SGA + SZ_ACT;
constexpr size_t WS_AG  = WS_SGG + SZ_ACT;
constexpr size_t WS_X1F = WS_AG + 2 * SZ_ACT;
constexpr size_t WS_END = WS_X1F + 2 * SZ_ACT;
static_assert((size_t)MT * D_FF * 2 <= 5 * SZ_ACT, "act overlays q..gv");

struct Args {
    const float *x_prompt, *x_sample, *cache_k, *cache_v, *rel_table, *norm1_g, *w_in, *q_norm_g, *k_norm_g, *lq1, *lk1, *lq2, *lk2, *subln_g, *gm_norm_g, *gm_w_s, *gm_b,
                *w_ab, *w_gb, *w_out, *norm2_g, *w_ffn_in, *w_ffn_out;
    float* out; unsigned char* ws; int ph_lo, ph_hi;
};

__device__ __forceinline__ unsigned f2bf(float f) { unsigned u = __builtin_bit_cast(unsigned, f); return (u + 0x7fffu + ((u >> 16) & 1u)) >> 16; }
__device__ __forceinline__ unsigned pk2(float lo, float hi) { return f2bf(lo) | (f2bf(hi) << 16); }
__device__ __forceinline__ float wave_sum(float v) {
#pragma unroll
    for (int o = 1; o < 64; o <<= 1) v += __shfl_xor(v, o);
    return v;
}
__device__ __forceinline__ void p0_transpose_item(const float* W, int N, int k0, int n0, bf16* WT, int ldt, int orow0, int koff, const float* scale, LAS float* scr, int lane) {
#pragma unroll 8
    for (int i = 0; i < 32; ++i) { const int kk = 2 * i + (lane >> 5); const float s = scale ? scale[k0 + kk] : 1.f; scr[kk * 33 + (lane & 31)] = W[(size_t)(k0 + kk) * N + n0 + (lane & 31)] * s; }
    asm volatile("s_waitcnt lgkmcnt(0)" ::: "memory");
    const int c = lane & 7;
#pragma unroll
    for (int j = 0; j < 4; ++j) { const int n = (lane >> 3) + 8 * j; const LAS float* s = scr + (8 * c) * 33 + n;
        v4u o; o.x = pk2(s[0 * 33], s[1 * 33]); o.y = pk2(s[2 * 33], s[3 * 33]); o.z = pk2(s[4 * 33], s[5 * 33]); o.w = pk2(s[6 * 33], s[7 * 33]);
        *(v4u*)(WT + (size_t)(orow0 + n) * ldt + koff + k0 + 8 * c) = o; }
    asm volatile("s_waitcnt lgkmcnt(0)" ::: "memory");
}
__device__ __forceinline__ int rel_bucket(int rel) {
    const int n = rel < 0 ? -rel : rel; int bk;
    if (n < 8) bk = n; else if (n < 12) bk = 8; else if (n < 16) bk = 9; else if (n < 23) bk = 10; else if (n < 32) bk = 11; else if (n < 46) bk = 12; else if (n < 64) bk = 13; else if (n < 91) bk = 14; else bk = 15;
    return (rel > 0 ? 16 : 0) + bk;
}

__device__ __forceinline__ void p0_prologue(const Args& a, LAS unsigned char* lds, int vcu, int G, const int wave) {
    unsigned char* ws = a.ws;
    const int lane = my_lane(), tid = wave * 64 + lane, gw = vcu * NWAVES + wave, NGW = G * NWAVES;
    LAS float* scr = (LAS float*)(lds + wave * 16384);
    constexpr int I1 = 16 * (IN_W / 32), I3 = 16 * 32, I5 = 16 * (2 * D_FF / 32), I6 = (D_FF / 64) * 32;
    constexpr int NITEMS = I1 + 3 * I3 + I5 + I6;
    for (int it = gw; it < NITEMS; it += NGW) {
        int r = it;
        if (r < I1) { const int nb = IN_W / 32, kb = r / nb, n0 = (r % nb) * 32, tile = n0 >> 8, L = n0 & 255, P = 128 * ((L >> 5) & 1) + 32 * (L >> 6);
            p0_transpose_item(a.w_in, IN_W, 64 * kb, n0, (bf16*)(ws + WS_BT1), 1024, tile * 256 + P, 0, a.norm1_g, scr, lane); continue; } r -= I1;
        if (r < I3) { const int kb = r / 32, n0 = (r % 32) * 32; p0_transpose_item(a.w_ab, 1024, 64 * kb, n0, (bf16*)(ws + WS_BT3), 2048, n0, 0, nullptr, scr, lane); continue; } r -= I3;
        if (r < I3) { const int kb = r / 32, n0 = (r % 32) * 32; p0_transpose_item(a.w_gb, 1024, 64 * kb, n0, (bf16*)(ws + WS_BT3), 2048, n0, 1024, nullptr, scr, lane); continue; } r -= I3;
        if (r < I3) { const int kb = r / 32, n0 = (r % 32) * 32; p0_transpose_item(a.w_out, 1024, 64 * kb, n0, (bf16*)(ws + WS_BT4), 1024, n0, 0, nullptr, scr, lane); continue; } r -= I3;
        if (r < I5) { const int nb = 2 * D_FF / 32, kb = r / nb, n0 = (r % nb) * 32, half = n0 >= D_FF ? 1 : 0, jh = n0 - half * D_FF, orow = (jh >> 7) * 256 + 128 * half + (jh & 127);
            p0_transpose_item(a.w_ffn_in, 2 * D_FF, 64 * kb, n0, (bf16*)(ws + WS_BT5), 1024, orow, 0, a.norm2_g, scr, lane); continue; } r -= I5;
        { const int kb = r / 32, n0 = (r % 32) * 32; p0_transpose_item(a.w_ffn_out, 1024, 64 * kb, n0, (bf16*)(ws + WS_BT6), D_FF, n0, 0, nullptr, scr, lane); }
    }
    for (int i = gw * 64 + lane; i < 8 * 128 * 128 / 4; i += NGW * 64) { const int e = i * 4, t = (e >> 7) & 127, s = e & 127; const f32x4 w = *(const f32x4*)(a.gm_w_s + e);
        const unsigned lo = pk2(s <= t ? w[0] : 0.f, s + 1 <= t ? w[1] : 0.f), hi = pk2(s + 2 <= t ? w[2] : 0.f, s + 3 <= t ? w[3] : 0.f);
        *(unsigned long long*)((bf16*)(ws + WS_WM) + e) = (unsigned long long)lo | ((unsigned long long)hi << 32); }
    for (int m = gw; m < MT; m += NGW) {
        const float* xrow = (m < MP) ? a.x_prompt + (size_t)m * 1024 : a.x_sample + (size_t)(m - MP) * 1024;
        const f32x4* xr = (const f32x4*)xrow + lane; f32x4 v[4]; float s = 0.f;
#pragma unroll
        for (int j = 0; j < 4; ++j) { v[j] = xr[64 * j]; s += (v[j][0] * v[j][0] + v[j][1] * v[j][1]) + (v[j][2] * v[j][2] + v[j][3] * v[j][3]); }
        s = wave_sum(s);
        if (lane == 0) ((float*)(ws + WS_R1))[m] = __builtin_amdgcn_rsqf(s * (1.0f / 1024.0f) + EPS);
        unsigned long long* o8 = (unsigned long long*)((bf16*)(ws + WS_XB) + (size_t)m * 1024) + lane;
#pragma unroll
        for (int j = 0; j < 4; ++j) o8[64 * j] = (unsigned long long)pk2(v[j][0], v[j][1]) | ((unsigned long long)pk2(v[j][2], v[j][3]) << 32);
    }
    if (blockIdx.x == 0) {
        float* misc = (float*)(ws + WS_MISC);
        for (int i = tid; i < 8 * 192; i += NWAVES * 64) { const int h = i / 192, idx = i % 192, rel = idx - 127;
            misc[i] = (idx < 191) ? a.rel_table[rel_bucket(rel) * 8 + h] * LOG2E : 0.f; }
        if (wave == 0) { const float s1 = wave_sum(a.lq1[lane] * a.lk1[lane]), s2 = wave_sum(a.lq2[lane] * a.lk2[lane]);
            if (lane == 0) misc[8 * 192] = __expf(s1) - __expf(s2) + LAM_INIT; }
    }
}

__global__ void __launch_bounds__(NWAVES * 64, 2) fwd_megakernel(Args args) {
    extern __shared__ __attribute__((aligned(16))) unsigned char lds[];
    cg::grid_group grid = cg::this_grid();
    LAS unsigned char* ldsl = (LAS unsigned char*)lds;
    const int wave = __builtin_amdgcn_readfirstlane(threadIdx.x >> 6);
    const int G = gridDim.x, bx = blockIdx.x, vcu = (G % 8 == 0) ? (bx % 8) * (G / 8) + bx / 8 : bx;
    unsigned char* ws = args.ws;
    const int lo = args.ph_lo, hi = args.ph_hi;
    if (threadIdx.x < 16) ((LAS unsigned*)(ldsl + LDS_MISC))[threadIdx.x] = 0u;
    __syncthreads();
    XcdBarrier bar = xcd_barrier_post((unsigned*)(ws + WS_CTL), (volatile LAS unsigned*)(ldsl + LDS_MISC));
#define IN(k) (lo <= (k) && (k) < hi)
#define SEAM(k) do { if (IN(k) && IN((k) + 1)) { if ((k) == 0) { asm volatile("s_waitcnt vmcnt(0)" ::: "memory"); __syncthreads(); grid.sync(); } else xcd_barrier(bar); } } while (0)
    if (IN(0)) { p0_prologue(args, ldsl, vcu, G, wave); __syncthreads(); }
    SEAM(0);
    if (IN(1)) {
        pg8::Gemm g{(const bf16*)(ws + WS_XB), (const bf16*)(ws + WS_BT1), MT, IN_W, 1024}; pg8::StaticOrder S; S.init(MT, IN_W, G, bx);
        pg8::EpiInProj E{(const float*)(ws + WS_R1), (bf16*)(ws + WS_Q),
                         args.out, (float*)(ws + WS_GVSS), args.q_norm_g, args.k_norm_g};
        pg8::gemm_phase<pg8::EpiInProj, pg8::StaticOrder, true, true>(ldsl, g, S, E, wave);
    }
    SEAM(1);
    if (IN(2)) {
        const float* misc = (const float*)(ws + WS_MISC);
        att::AttnArgs A{(const bf16*)(ws + WS_Q), (const bf16*)(ws + WS_K), (const bf16*)(ws + WS_V), args.cache_k, args.cache_v, args.out + O_KS, args.out + O_VS,
                        (bf16*)(ws + WS_AG), misc, misc + 8 * 192, args.subln_g};
        for (int u = vcu; u < DEC_BATCH * NH; u += G) att::attn_unit<true>(A, u >> 3, u & 7, 0, (char*)lds, wave);
        for (int w = vcu; w < BATCH * NH * 2; w += G) { const int bh = w >> 1, s0 = 4 * (w & 1);
            for (int i = 0; i < 4; ++i) { att::attn_unit<false>(A, bh >> 3, bh & 7, s0 + i, (char*)lds, wave); att::attn_unit<false>(A, bh >> 3, bh & 7, 15 - (s0 + i), (char*)lds, wave); } }
        att::SguArgs SG{(const bf16*)(ws + WS_GU), (const bf16*)(ws + WS_GV), (const float*)(ws + WS_GVSS), (const bf16*)(ws + WS_WM), args.gm_norm_g, args.gm_b, (bf16*)(ws + WS_AG), args.out};
        for (int it = vcu; it < (MP / 128) * 8 + DEC_BATCH * 8; it += G) {
            if (it < (MP / 128) * 8) att::sgu_item(SG, (it >> 3) * 128, it & 7, false, (char*)lds, wave);
            else { const int r = it - (MP / 128) * 8; att::sgu_item(SG, MP + (r >> 3) * 64, r & 7, true, (char*)lds, wave); }
        }
    }
    SEAM(2);
    if (IN(3)) {
        pg8::Gemm g{(const bf16*)(ws + WS_AG), (const bf16*)(ws + WS_BT3), MT, 1024, 2048}; pg8::StaticOrder S; S.init(MT, 1024, G, bx);
        pg8::EpiMerge E{(const bf16*)(ws + WS_SGA), (const bf16*)(ws + WS_SGG), (bf16*)(ws + WS_XB)};
        pg8::gemm_phase<pg8::EpiMerge, pg8::StaticOrder, true, true>(ldsl, g, S, E, wave);
    }
    SEAM(3);
    if (IN(4)) {
        pg8::Gemm g{(const bf16*)(ws + WS_XB), (const bf16*)(ws + WS_BT4), MT, 1024, 1024}; pg8::StaticOrder S; S.init(MT, 1024, G, bx);
        pg8::EpiOutRes E{args.x_prompt, args.x_sample, (float*)(ws + WS_X1F), (bf16*)(ws + WS_AG), (float*)(ws + WS_X1SS)};
        pg8::gemm_phase<pg8::EpiOutRes, pg8::StaticOrder, true, true>(ldsl, g, S, E, wave);
    }
    SEAM(4);
    if (IN(5)) {
        pg8::Gemm g{(const bf16*)(ws + WS_AG), (const bf16*)(ws + WS_BT5), MT, 2 * D_FF, 1024}; pg8::StaticOrder S; S.init(MT, 2 * D_FF, G, bx);
        pg8::EpiSwiGLU E{(const float*)(ws + WS_X1SS), (bf16*)(ws + WS_Q)};
        pg8::gemm_phase<pg8::EpiSwiGLU, pg8::StaticOrder, true, true>(ldsl, g, S, E, wave);
    }
    SEAM(5);
    if (IN(6)) {
        pg8::Gemm g{(const bf16*)(ws + WS_Q), (const bf16*)(ws + WS_BT6), MT, 1024, D_FF}; pg8::StaticOrder S; S.init(MT, 1024, G, bx);
        pg8::EpiFinal E{(const float*)(ws + WS_X1F), args.out};
        pg8::gemm_phase<pg8::EpiFinal, pg8::StaticOrder, true, true>(ldsl, g, S, E, wave);
    }
#undef IN
#undef SEAM
}

#ifndef MK_N_LAUNCHES
#define MK_N_LAUNCHES 1
#endif
extern "C" void kernel_launch(void* const* d_in, const int* in_sizes, int n_in, void* d_out, int out_size, void* d_ws, size_t ws_size, hipStream_t stream) {
    static int grid = 0;
    if (grid == 0) {
        if (n_in != 23 || (size_t)out_size != O_END || ws_size < WS_END) { fprintf(stderr, "kernel_launch: unexpected shapes: n_in %d out %d ws %zu (need %zu)\n", n_in, out_size, ws_size, (size_t)WS_END); grid = -1; return; }
        int dev = 0, cus = 0, per_cu = 0;
        if (hipGetDevice(&dev) != hipSuccess || hipDeviceGetAttribute(&cus, hipDeviceAttributeMultiprocessorCount, dev) != hipSuccess) { grid = -1; return; }
        if (hipFuncSetAttribute((const void*)fwd_megakernel, hipFuncAttributeMaxDynamicSharedMemorySize, LDS_BYTES) != hipSuccess) { fprintf(stderr, "kernel_launch: hipFuncSetAttribute failed\n"); grid = -1; return; }
        if (hipOccupancyMaxActiveBlocksPerMultiprocessor(&per_cu, (const void*)fwd_megakernel, NWAVES * 64, LDS_BYTES) != hipSuccess || per_cu < 1) { fprintf(stderr, "kernel_launch: occupancy query says %d\n", per_cu); grid = -1; return; }
        grid = cus;
    }
    if (grid < 0) return;
    if (hipMemsetAsync((char*)d_ws + WS_CTL, 0, CTL_BYTES, stream) != hipSuccess) { fprintf(stderr, "kernel_launch: memset failed\n"); return; }
    Args a{};
    const float** p = (const float**)&a;
    for (int i = 0; i < 23; ++i) p[i] = (const float*)d_in[i];
    a.out = (float*)d_out; a.ws = (unsigned char*)d_ws;
#if MK_N_LAUNCHES == 1
    a.ph_lo = 0; a.ph_hi = 7;
    void* kargs[] = {&a};
    hipError_t e = hipLaunchCooperativeKernel((const void*)fwd_megakernel, dim3(grid), dim3(NWAVES * 64), kargs, LDS_BYTES, stream);
    if (e != hipSuccess) fprintf(stderr, "cooperative launch failed: %s (grid %d)\n", hipGetErrorString(e), grid);
#else
    for (int ph = 0; ph < 7; ++ph) { a.ph_lo = ph; a.ph_hi = ph + 1;
        void* kargs[] = {&a};
        hipError_t e = hipLaunchCooperativeKernel((const void*)fwd_megakernel, dim3(grid), dim3(NWAVES * 64), kargs, LDS_BYTES, stream);
        if (e != hipSuccess) { fprintf(stderr, "launch %d failed: %s (grid %d)\n", ph, hipGetErrorString(e), grid); break; } }
#endif
}
```
